# Optimizing an MI355X kernel written in HIP

```python
import math
import jax
import jax.numpy as jnp
from jax import lax
import numpy as np

D_MODEL = 2048
BATCH = 4
SEQ = 2048
DEPTH = 2

RMS_EPS = 1e-6
PLE_DIM = 256
SSD_HEAD_DIM = 64
SSD_INNER = D_MODEL
SSD_HEADS = SSD_INNER // SSD_HEAD_DIM
SSD_GROUPS = 4
SSD_STATE = 128
SSD_BC = SSD_GROUPS * SSD_STATE
SSD_CHUNK = 256
CONV_K = 4
CONV_CH = SSD_INNER + 2 * SSD_BC
POOL_WINDOWS = (2, 4, 8, 16)
POOL_WIDTH = D_MODEL
POOL_GROUPS = len(POOL_WINDOWS)
POOL_GROUP_W = POOL_WIDTH // POOL_GROUPS
ATTN_PATTERNS = ((128, 1), (512, 4), (2048, 16))
ATTN_HEAD_DIM = 128
ATTN_HEADS_PER_GROUP = 4
ATTN_HEADS = ATTN_HEADS_PER_GROUP * len(ATTN_PATTERNS)
ATTN_QKV_W = ATTN_HEADS * ATTN_HEAD_DIM
ATTN_OUT = ATTN_HEADS_PER_GROUP * ATTN_HEAD_DIM
ATTN_BLOCK = 128
N_BRANCHES = 3
IN_SIZES = (SSD_INNER, CONV_CH, SSD_HEADS,
            POOL_WIDTH, POOL_WIDTH,
            ATTN_QKV_W, ATTN_QKV_W, ATTN_QKV_W,
            ATTN_OUT,
            N_BRANCHES * D_MODEL)
N_IN = sum(IN_SIZES)
IN_SPLITS = tuple(int(s) for s in np.cumsum(IN_SIZES)[:-1])

kernel_name = "hybrid_ssd_pool_dilated_attn_gated_merge"


def _rms_norm(x, g):
    x32 = x.astype(jnp.float32)
    y = x32 * lax.rsqrt(jnp.mean(x32 * x32, axis=-1, keepdims=True) + RMS_EPS)
    return y.astype(x.dtype) * g


def _causal_depthwise_conv(u, w, bias):
    k, c = w.shape
    out = lax.conv_general_dilated(u, w[:, None, :], window_strides=(1,), padding=[(k - 1, 0)],
                                   dimension_numbers=("NWC", "WIO", "NWC"), feature_group_count=c)
    return out + bias


def _segsum(a):
    t = a.shape[-1]
    cs = jnp.cumsum(a, axis=-1)
    seg = cs[..., :, None] - cs[..., None, :]
    mask = jnp.tril(jnp.ones((t, t), dtype=bool))
    return jnp.where(mask, seg, -jnp.inf)


def _ssd_scan(xh, da, bm, cm):
    b, seq, nh, hp = xh.shape
    ng, ns = bm.shape[2], bm.shape[3]
    r = nh // ng
    q = math.gcd(SSD_CHUNK, seq)
    nc = seq // q
    x_c = xh.reshape(b, nc, q, ng, r, hp)
    a_c = da.reshape(b, nc, q, ng, r).transpose(0, 3, 4, 1, 2)
    b_c = bm.reshape(b, nc, q, ng, ns)
    c_c = cm.reshape(b, nc, q, ng, ns)
    a_cum = jnp.cumsum(a_c, axis=-1)
    l_mat = jnp.exp(_segsum(a_c))
    cb = jnp.einsum("bclgn,bcsgn->bgcls", c_c, b_c)
    y_diag = jnp.einsum("bgrcls,bcsgrp->bclgrp", cb[:, :, None] * l_mat, x_c)
    decay_states = jnp.exp(a_cum[..., -1:] - a_cum)
    states = jnp.einsum("bclgn,bgrcl,bclgrp->bcgrpn", b_c, decay_states, x_c)
    states = jnp.concatenate([jnp.zeros_like(states[:, :1]), states], axis=1)
    chunk_decay = jnp.exp(_segsum(jnp.pad(a_cum[..., -1], ((0, 0), (0, 0), (0, 0), (1, 0)))))
    states = jnp.einsum("bgrzc,bcgrpn->bzgrpn", chunk_decay, states)[:, :-1]
    y_off = jnp.einsum("bclgn,bcgrpn,bgrcl->bclgrp", c_c, states, jnp.exp(a_cum))
    return (y_diag + y_off).reshape(b, seq, nh, hp)


def _ssd_branch(z, xbc, dt, conv_w, conv_b, dt_bias, a_log, d_skip, norm_g):
    b, seq, _ = z.shape
    xbc = jax.nn.silu(_causal_depthwise_conv(xbc, conv_w, conv_b))
    xs = xbc[..., :SSD_INNER].reshape(b, seq, SSD_HEADS, SSD_HEAD_DIM)
    bm = xbc[..., SSD_INNER:SSD_INNER + SSD_BC].reshape(b, seq, SSD_GROUPS, SSD_STATE)
    cm = xbc[..., SSD_INNER + SSD_BC:].reshape(b, seq, SSD_GROUPS, SSD_STATE)
    dt32 = jax.nn.softplus(dt.astype(jnp.float32) + dt_bias.astype(jnp.float32))
    a = -jnp.exp(a_log.astype(jnp.float32))
    xs32 = xs.astype(jnp.float32)
    y = _ssd_scan(xs32 * dt32[..., None], dt32 * a, bm.astype(jnp.float32), cm.astype(jnp.float32))
    y = y + d_skip.astype(jnp.float32)[:, None] * xs32
    y = y.reshape(b, seq, SSD_INNER).astype(z.dtype)
    return _rms_norm(y * jax.nn.silu(z), norm_g)


def _pool_branch(u, z, pool_w, pool_scale):
    b, seq, _ = u.shape
    ug = u.reshape(b, seq, POOL_GROUPS, POOL_GROUP_W).astype(jnp.float32)
    cs = jnp.cumsum(ug, axis=1)
    pos = jnp.arange(seq)
    pooled = []
    for gi, w in enumerate(POOL_WINDOWS):
        c = cs[:, :, gi]
        shifted = jnp.pad(c, ((0, 0), (w, 0), (0, 0)))[:, :seq]
        count = jnp.minimum(pos + 1, w).astype(jnp.float32)[:, None]
        pooled.append((c - shifted) / count)
    pooled = (jnp.stack(pooled, axis=2) - ug).astype(u.dtype)
    mixed = jnp.einsum("blgc,gcd->blgd", pooled, pool_w).reshape(b, seq, POOL_WIDTH)
    return mixed * pool_scale * jax.nn.silu(z)


def _dilated_window_attn(q, k, v, window, dilation):
    b, seq, nh, hd = q.shape
    wk = window // dilation
    ld = seq // dilation
    bq = math.gcd(ATTN_BLOCK, ld)
    nb = ld // bq

    def strided(t):
        return t.reshape(b, ld, dilation, nh, hd).transpose(0, 2, 3, 1, 4)

    qs, ks, vs = strided(q), strided(k), strided(v)
    qb = qs.reshape(b, dilation, nh, nb, bq, hd)
    pad = ((0, 0), (0, 0), (0, 0), (wk, 0), (0, 0))
    idx = jnp.arange(nb)[:, None] * bq + jnp.arange(bq + wk)[None, :]
    kb = jnp.pad(ks, pad)[:, :, :, idx]
    vb = jnp.pad(vs, pad)[:, :, :, idx]
    s = jnp.einsum("bdhnqc,bdhnkc->bdhnqk", qb, kb).astype(jnp.float32) * (hd ** -0.5)
    qi = jnp.arange(bq)[:, None]
    kj = jnp.arange(bq + wk)[None, :]
    kpos = jnp.arange(nb)[:, None, None] * bq + kj[None] - wk
    valid = (kj >= qi)[None] & (kj <= qi + wk)[None] & (kpos >= 0)
    s = jnp.where(valid, s, -jnp.inf)
    m = jnp.max(s, axis=-1, keepdims=True)
    e = jnp.exp(s - m)
    den = jnp.sum(e, axis=-1, keepdims=True)
    o = jnp.einsum("bdhnqk,bdhnkc->bdhnqc", (e / den).astype(v.dtype), vb)
    lse = (m + jnp.log(den))[..., 0]
    o = o.reshape(b, dilation, nh, ld, hd).transpose(0, 3, 1, 2, 4).reshape(b, seq, nh, hd)
    lse = lse.reshape(b, dilation, nh, ld).transpose(0, 3, 1, 2).reshape(b, seq, nh)
    return o, lse


def _attn_branch(q, k, v, z, q_norm_g, k_norm_g):
    b, seq, _ = q.shape
    q = _rms_norm(q.reshape(b, seq, ATTN_HEADS, ATTN_HEAD_DIM), q_norm_g)
    k = _rms_norm(k.reshape(b, seq, ATTN_HEADS, ATTN_HEAD_DIM), k_norm_g)
    v = v.reshape(b, seq, ATTN_HEADS, ATTN_HEAD_DIM)
    outs, lses = [], []
    for gi, (window, dilation) in enumerate(ATTN_PATTERNS):
        hs = slice(gi * ATTN_HEADS_PER_GROUP, (gi + 1) * ATTN_HEADS_PER_GROUP)
        o, lse = _dilated_window_attn(q[:, :, hs], k[:, :, hs], v[:, :, hs], window, dilation)
        outs.append(o)
        lses.append(lse)
    wts = jax.nn.softmax(jnp.stack(lses, axis=0), axis=0)
    comb = jnp.sum(wts[..., None].astype(v.dtype) * jnp.stack(outs, axis=0), axis=0)
    return comb.reshape(b, seq, ATTN_OUT) * jax.nn.silu(z)


def setup_inputs(seed: int = 0) -> dict:
    key = jax.random.key(seed)
    ks = jax.random.split(key, 24)
    f32 = jnp.float32

    def nrm(k, shape, scale):
        return jax.random.normal(k, shape, f32) * scale

    dt0 = jnp.exp(jax.random.uniform(ks[6], (DEPTH, SSD_HEADS), f32,
                                     minval=math.log(1e-3), maxval=math.log(1e-1)))
    return {
        "x": nrm(ks[0], (BATCH, SEQ, D_MODEL), 1.0),
        "p": nrm(ks[1], (DEPTH, BATCH, SEQ, PLE_DIM), 1.0),
        "norm_g": 1.0 + nrm(ks[2], (DEPTH, D_MODEL), 0.02),
        "w_in": nrm(ks[3], (DEPTH, D_MODEL, N_IN), D_MODEL ** -0.5),
        "conv_w": nrm(ks[4], (DEPTH, CONV_K, CONV_CH), CONV_K ** -0.5),
        "conv_b": nrm(ks[5], (DEPTH, CONV_CH), 0.02),
        "dt_bias": dt0 + jnp.log(-jnp.expm1(-dt0)),
        "a_log": jnp.log(jax.random.uniform(ks[7], (DEPTH, SSD_HEADS), f32, minval=1.0, maxval=16.0)),
        "d_skip": 1.0 + nrm(ks[8], (DEPTH, SSD_HEADS), 0.1),
        "ssd_norm_g": 1.0 + nrm(ks[9], (DEPTH, SSD_INNER), 0.02),
        "w_br_ssd": nrm(ks[10], (DEPTH, SSD_INNER, D_MODEL), SSD_INNER ** -0.5),
        "pool_w": nrm(ks[11], (DEPTH, POOL_GROUPS, POOL_GROUP_W, POOL_GROUP_W), POOL_GROUP_W ** -0.5),
        "pool_scale": 1.0 + nrm(ks[12], (DEPTH, POOL_WIDTH), 0.1),
        "w_br_pool": nrm(ks[13], (DEPTH, POOL_WIDTH, D_MODEL), POOL_WIDTH ** -0.5),
        "q_norm_g": 1.0 + nrm(ks[14], (DEPTH, ATTN_HEAD_DIM), 0.02),
        "k_norm_g": 1.0 + nrm(ks[15], (DEPTH, ATTN_HEAD_DIM), 0.02),
        "w_br_attn": nrm(ks[16], (DEPTH, ATTN_OUT, D_MODEL), ATTN_OUT ** -0.5),
        "w_out": nrm(ks[17], (DEPTH, D_MODEL, D_MODEL), D_MODEL ** -0.5),
        "ple_norm_g": 1.0 + nrm(ks[18], (DEPTH, D_MODEL), 0.02),
        "w_ple_gate": nrm(ks[19], (DEPTH, D_MODEL, D_MODEL), D_MODEL ** -0.5),
        "w_ple_proj": nrm(ks[20], (DEPTH, PLE_DIM, D_MODEL), PLE_DIM ** -0.5),
    }


def reference(x, p, norm_g, w_in, conv_w, conv_b, dt_bias, a_log, d_skip, ssd_norm_g, w_br_ssd,
              pool_w, pool_scale, w_br_pool, q_norm_g, k_norm_g, w_br_attn, w_out,
              ple_norm_g, w_ple_gate, w_ple_proj):
    b, seq, _ = x.shape
    for i in range(DEPTH):
        h = _rms_norm(x, norm_g[i])
        proj = jnp.einsum("bld,dn->bln", h, w_in[i])
        (z_ssd, xbc, dt, u_pool, z_pool, q, k, v, z_attn, gate_logits) = jnp.split(proj, IN_SPLITS, axis=-1)
        y_ssd = _ssd_branch(z_ssd, xbc, dt, conv_w[i], conv_b[i], dt_bias[i], a_log[i], d_skip[i], ssd_norm_g[i])
        y_pool = _pool_branch(u_pool, z_pool, pool_w[i], pool_scale[i])
        y_attn = _attn_branch(q, k, v, z_attn, q_norm_g[i], k_norm_g[i])
        gates = jax.nn.sigmoid(gate_logits.reshape(b, seq, N_BRANCHES, D_MODEL))
        merged = (gates[:, :, 0] * (y_ssd @ w_br_ssd[i])
                  + gates[:, :, 1] * (y_pool @ w_br_pool[i])
                  + gates[:, :, 2] * (y_attn @ w_br_attn[i]))
        x = x + merged @ w_out[i]
        ple_gate = jax.nn.sigmoid(_rms_norm(x, ple_norm_g[i]) @ w_ple_gate[i])
        x = x + ple_gate * (p[i] @ w_ple_proj[i])
    return x
```

```cpp
#include <hip/hip_runtime.h>
#include <hip/hip_cooperative_groups.h>
#include <cstdio>
namespace cg = cooperative_groups;
namespace pg8 {
#define PG8_LAS __attribute__((address_space(3)))
typedef unsigned short bf16_t;
typedef short bf16x8 __attribute__((ext_vector_type(8)));
typedef float f32x4 __attribute__((ext_vector_type(4)));
typedef unsigned u32x4 __attribute__((ext_vector_type(4)));
constexpr int BM = 256, BK = 64, HALF = 128, HTB = HALF * BK * 2  , STAGE_BYTES = 8 * HTB, NXCD = 8, WGM = 8;

__host__ __device__ __forceinline__ int lds_byte(int r, int c) { const int st = (r >> 4) * 2 + (c >> 5), rr = r & 15, cc = c & 31, ob = rr * 64 + cc * 2; return st * 1024 + (ob ^ (((ob >> 9) & 1) << 5)); }
__host__ __device__ __forceinline__ void stage_rc(int b, int& R, int& C) { const int st = b / 1024, sb = b % 1024, swz = sb ^ (((sb >> 9) & 1) << 5); R = (st >> 1) * 16 + swz / 64; C = (st & 1) * 32 + (swz % 64) / 2; }
__host__ __device__ __forceinline__ int perm32(int rho) { const int n = rho >> 4, i = rho & 15; return 8 * (i >> 2) + 4 * n + (i & 3); }

struct Unit { int pm, pn; };
struct Gemm { const bf16_t* A; const bf16_t* Bt; int M, N, K; };

struct StaticOrder {
    int nM, nN, nwg, G, c;
    __host__ __device__ void init(int M, int N, int G_, int c_) { nM = M / BM; nN = N / BM; nwg = nM * nN; G = G_; c = c_; }
    __host__ __device__ bool next(int i, Unit& u) const {
        const long L = (long)i * G + c; if (L >= nwg) return false;
        int wgid = (int)L; { const int q = nwg / NXCD, r = nwg % NXCD, xcd = wgid % NXCD, off = wgid / NXCD; wgid = (xcd < r ? xcd * (q + 1) : r * (q + 1) + (xcd - r) * q) + off; }
        const int nig = WGM * nN, gid = wgid / nig, fm = gid * WGM, gsz = (nM - fm) < WGM ? (nM - fm) : WGM;
        u.pm = fm + ((wgid % nig) % gsz); u.pn = (wgid % nig) / gsz; return true;
    }
    __device__ __forceinline__ void a_ready(const Unit&) const {}
    __device__ __forceinline__ void done(const Unit&) const {}
};
__device__ __forceinline__ unsigned cvt_pk_bf16(float lo, float hi) { unsigned r; asm volatile("v_cvt_pk_bf16_f32 %0, %1, %2" : "=v"(r) : "v"(lo), "v"(hi)); return r; }
typedef float f32x2 __attribute__((ext_vector_type(2)));
typedef unsigned u32x2 __attribute__((ext_vector_type(2)));
__device__ __forceinline__ float bf2f(unsigned short b) { return __uint_as_float(((unsigned)b) << 16); }
__device__ __forceinline__ float bflo(unsigned w) { return __uint_as_float(w << 16); }
__device__ __forceinline__ float bfhi(unsigned w) { return __uint_as_float(w & 0xffff0000u); }
__device__ __forceinline__ float sigmoidf_(float x) { return 1.0f / (1.0f + __expf(-x)); }
__device__ __forceinline__ float siluf_(float x) { return x / (1.0f + __expf(-x)); }

struct EpiF32 {
    static constexpr bool PERM = false, AFTER_DRAIN = false;
    float* C; int ldc;
    __device__ __forceinline__ void operator()(const f32x4 (&acc)[2][2][4][2], const Unit& u, int wr, int wc, int fr, int fq) const {
        const int row0 = u.pm * BM + wr * 64 + fr, col0 = u.pn * BM + wc * 32 + 4 * fq;
#pragma unroll
        for (int ai = 0; ai < 2; ++ai)
#pragma unroll
            for (int m = 0; m < 4; ++m) { float* rowp = C + (size_t)(row0 + ai * HALF + m * 16) * ldc + col0;
#pragma unroll
                for (int bj = 0; bj < 2; ++bj)
#pragma unroll
                    for (int n = 0; n < 2; ++n) *(f32x4*)(rowp + bj * HALF + n * 16) = acc[ai][bj][m][n]; }
    }
};
struct EpiBf16 {
    static constexpr bool PERM = true, AFTER_DRAIN = false;
    bf16_t* O; int ldc;
    __device__ __forceinline__ void operator()(const f32x4 (&acc)[2][2][4][2], const Unit& u, int wr, int wc, int fr, int fq) const {
        const int row0 = u.pm * BM + wr * 64 + fr; const int col0 = u.pn * BM + wc * 32 + 8 * fq;
#pragma unroll
        for (int ai = 0; ai < 2; ++ai)
#pragma unroll
            for (int m = 0; m < 4; ++m) { bf16_t* rowp = O + (size_t)(row0 + ai * HALF + m * 16) * ldc + col0;
#pragma unroll
                for (int bj = 0; bj < 2; ++bj) { const f32x4 v0 = acc[ai][bj][m][0], v1 = acc[ai][bj][m][1];
                    u32x4 w; w.x = cvt_pk_bf16(v0[0], v0[1]); w.y = cvt_pk_bf16(v0[2], v0[3]); w.z = cvt_pk_bf16(v1[0], v1[1]); w.w = cvt_pk_bf16(v1[2], v1[3]);
                    *(u32x4*)(rowp + bj * HALF) = w; } }
    }
};
struct EpiPool {
    static constexpr bool PERM = true, AFTER_DRAIN = false;
    bf16_t* O; const bf16_t* Z; int ldz; const float* scale;
    __device__ __forceinline__ void operator()(const f32x4 (&acc)[2][2][4][2], const Unit& u, int wr, int wc, int fr, int fq) const {
        const int row0 = (u.pm & 31) * BM + wr * 64 + fr; const int col0 = u.pn * BM + wc * 32 + 8 * fq;
#pragma unroll
        for (int bj = 0; bj < 2; ++bj) {
            const f32x4 s0 = *(const f32x4*)(scale + col0 + bj * HALF), s1 = *(const f32x4*)(scale + col0 + bj * HALF + 4);
#pragma unroll
            for (int ai = 0; ai < 2; ++ai)
#pragma unroll
                for (int m = 0; m < 4; ++m) { const size_t row = (size_t)(row0 + ai * HALF + m * 16);
                    const u32x4 z = *(const u32x4*)(Z + row * ldz + col0 + bj * HALF);
                    const f32x4 v0 = acc[ai][bj][m][0], v1 = acc[ai][bj][m][1];
                    u32x4 w;
                    w.x = cvt_pk_bf16(v0[0] * s0[0] * siluf_(bflo(z.x)), v0[1] * s0[1] * siluf_(bfhi(z.x)));
                    w.y = cvt_pk_bf16(v0[2] * s0[2] * siluf_(bflo(z.y)), v0[3] * s0[3] * siluf_(bfhi(z.y)));
                    w.z = cvt_pk_bf16(v1[0] * s1[0] * siluf_(bflo(z.z)), v1[1] * s1[1] * siluf_(bfhi(z.z)));
                    w.w = cvt_pk_bf16(v1[2] * s1[2] * siluf_(bflo(z.w)), v1[3] * s1[3] * siluf_(bfhi(z.w)));
                    *(u32x4*)(O + row * 2048 + col0 + bj * HALF) = w; } }
    }
};
template <int MODE> struct EpiMerge {
    static constexpr bool PERM = false, AFTER_DRAIN = false;
    const bf16_t* GL; int ldg; float* MF; bf16_t* MB;
    __device__ __forceinline__ void operator()(const f32x4 (&acc)[2][2][4][2], const Unit& u, int wr, int wc, int fr, int fq) const {
        const int row0 = u.pm * BM + wr * 64 + fr, col0 = u.pn * BM + wc * 32 + 4 * fq;
#pragma unroll
        for (int ai = 0; ai < 2; ++ai)
#pragma unroll
            for (int m = 0; m < 4; ++m) { const size_t row = (size_t)(row0 + ai * HALF + m * 16);
#pragma unroll
                for (int bj = 0; bj < 2; ++bj)
#pragma unroll
                    for (int n = 0; n < 2; ++n) { const int col = col0 + bj * HALF + n * 16;
                        const u32x2 g = *(const u32x2*)(GL + row * ldg + col);
                        f32x4 v = acc[ai][bj][m][n];
                        v[0] *= sigmoidf_(bflo(g.x)); v[1] *= sigmoidf_(bfhi(g.x)); v[2] *= sigmoidf_(bflo(g.y)); v[3] *= sigmoidf_(bfhi(g.y));
                        if (MODE >= 1) v += *(const f32x4*)(MF + row * 2048 + col);
                        if (MODE < 2) *(f32x4*)(MF + row * 2048 + col) = v;
                        else { u32x2 w; w.x = cvt_pk_bf16(v[0], v[1]); w.y = cvt_pk_bf16(v[2], v[3]); *(u32x2*)(MB + row * 2048 + col) = w; } } }
    }
};
struct EpiResid {
    static constexpr bool PERM = false, AFTER_DRAIN = false;
    const float* XIN; float* OUT;
    __device__ __forceinline__ void operator()(const f32x4 (&acc)[2][2][4][2], const Unit& u, int wr, int wc, int fr, int fq) const {
        const int row0 = u.pm * BM + wr * 64 + fr, col0 = u.pn * BM + wc * 32 + 4 * fq;
#pragma unroll
        for (int ai = 0; ai < 2; ++ai)
#pragma unroll
            for (int m = 0; m < 4; ++m) { const size_t row = (size_t)(row0 + ai * HALF + m * 16);
#pragma unroll
                for (int bj = 0; bj < 2; ++bj)
#pragma unroll
                    for (int n = 0; n < 2; ++n) { const size_t idx = row * 2048 + col0 + bj * HALF + n * 16;
                        *(f32x4*)(OUT + idx) = *(const f32x4*)(XIN + idx) + acc[ai][bj][m][n]; } }
    }
};
struct EpiPle {
    static constexpr bool PERM = false, AFTER_DRAIN = false;
    const float* PP; float* OUT;
    __device__ __forceinline__ void operator()(const f32x4 (&acc)[2][2][4][2], const Unit& u, int wr, int wc, int fr, int fq) const {
        const int row0 = u.pm * BM + wr * 64 + fr, col0 = u.pn * BM + wc * 32 + 4 * fq;
#pragma unroll
        for (int ai = 0; ai < 2; ++ai)
#pragma unroll
            for (int m = 0; m < 4; ++m) { const size_t row = (size_t)(row0 + ai * HALF + m * 16);
#pragma unroll
                for (int bj = 0; bj < 2; ++bj)
#pragma unroll
                    for (int n = 0; n < 2; ++n) { const size_t idx = row * 2048 + col0 + bj * HALF + n * 16;
                        const f32x4 a = acc[ai][bj][m][n], pp = *(const f32x4*)(PP + idx); f32x4 o = *(const f32x4*)(OUT + idx);
                        o[0] += sigmoidf_(a[0]) * pp[0]; o[1] += sigmoidf_(a[1]) * pp[1]; o[2] += sigmoidf_(a[2]) * pp[2]; o[3] += sigmoidf_(a[3]) * pp[3];
                        *(f32x4*)(OUT + idx) = o; } }
    }
};
struct PoolOrder {
    int G, c;
    __device__ bool next(int i, Unit& u) const {
        const int L = i * G + c; if (L >= 256) return false;
        const int g = L >> 6, rem = L & 63, mt = rem >> 1, nt = rem & 1;
        u.pm = g * 32 + mt; u.pn = g * 2 + nt; return true;
    }
    __device__ __forceinline__ void a_ready(const Unit&) const {}
    __device__ __forceinline__ void done(const Unit&) const {}
};
template <class Epi, class Sched, bool STAMP = false>
__device__ __forceinline__ void gemm_phase(PG8_LAS unsigned char* lds, const Gemm g, const Sched& S, const Epi& E, unsigned long long* stamps) {
    int tid_ = threadIdx.x; asm volatile("" : "+v"(tid_));
    const int tid = tid_, wid = __builtin_amdgcn_readfirstlane(tid >> 6), lane = tid & 63, wr = wid >> 2, wc = wid & 3, fr = lane & 15, fq = lane >> 4;
    const int K = g.K, nt = K / BK;
    int ts_lo = 0, ts_hi = 0, nts = 0; const unsigned long long rt_entry = STAMP ? (unsigned long long)wall_clock64() : 0ull;
#define PG8_STAMP() do { if (STAMP && wid == 0 && nts < 64) { const unsigned long long _c = (unsigned long long)clock64(); \
        ts_lo = (lane == nts) ? (int)(unsigned)_c : ts_lo; ts_hi = (lane == nts) ? (int)(unsigned)(_c >> 32) : ts_hi; ++nts; } } while (0)
    PG8_STAMP();
    unsigned voffA[2], voffB[2];
#pragma unroll
    for (int i = 0; i < 2; ++i) { int R, C; stage_rc(tid * 16 + i * 8192, R, C); const int Rb = Epi::PERM ? ((R & ~31) + perm32(R & 31)) : R;
        voffA[i] = (unsigned)(R * K + C) * 2u; voffB[i] = (unsigned)(Rb * K + C) * 2u; }
    const size_t kstep = (size_t)(BK * 2);
    const size_t hstep = (size_t)HALF * K * 2;
    const size_t tstep = 2 * hstep;
    const unsigned ldsw = (unsigned)wid * 1024u;
    const int aoff = lds_byte(wr * 64 + fr, fq * 8), boff = lds_byte(wc * 32 + fr, fq * 8);
#define PG8_SA(b, h) (((b) * 2 + (h)) * HTB)
#define PG8_SB(b, h) ((4 + (b) * 2 + (h)) * HTB)
#define PG8_STAGE(bufoff, gbase, voff) do { _Pragma("unroll") for (int _i = 0; _i < 2; ++_i) \
        __builtin_amdgcn_global_load_lds((const unsigned*)((const char*)(gbase) + (voff)[_i]), (PG8_LAS unsigned*)(lds + (bufoff) + ldsw + _i * 8192), 16, 0, 0); } while (0)
#define PG8_LDA(dst, b, h) do { _Pragma("unroll") for (int m = 0; m < 4; ++m) _Pragma("unroll") for (int k = 0; k < 2; ++k) dst[m][k] = *(const PG8_LAS bf16x8*)(lds + PG8_SA(b, h) + aoff + m * 2048 + k * 1024); } while (0)
#define PG8_LDB(dst, b, h) do { _Pragma("unroll") for (int n = 0; n < 2; ++n) _Pragma("unroll") for (int k = 0; k < 2; ++k) dst[n][k] = *(const PG8_LAS bf16x8*)(lds + PG8_SB(b, h) + boff + n * 2048 + k * 1024); } while (0)
#define PG8_MMA(ai, bj, At, Bt) do { __builtin_amdgcn_s_setprio(1); _Pragma("unroll") for (int m = 0; m < 4; ++m) _Pragma("unroll") for (int n = 0; n < 2; ++n) _Pragma("unroll") for (int k = 0; k < 2; ++k) \
        acc[ai][bj][m][n] = __builtin_amdgcn_mfma_f32_16x16x32_bf16(Bt[n][k], At[m][k], acc[ai][bj][m][n], 0, 0, 0); __builtin_amdgcn_s_setprio(0); } while (0)
#define PG8_WAIT_V(n) asm volatile("s_waitcnt vmcnt(" #n ")" ::: "memory")
#define PG8_WAIT_L(n) asm volatile("s_waitcnt lgkmcnt(" #n ")" ::: "memory")
#define PG8_BAR __builtin_amdgcn_s_barrier()
#define PG8_SCHED __builtin_amdgcn_sched_barrier(0)
    Unit cur, nxt; int ui = 0;
    if (!S.next(0, cur)) return;
    f32x4 acc[2][2][4][2];
#pragma unroll
    for (int a = 0; a < 2; ++a)
#pragma unroll
        for (int b = 0; b < 2; ++b)
#pragma unroll
            for (int m = 0; m < 4; ++m)
#pragma unroll
                for (int n = 0; n < 2; ++n) acc[a][b][m][n] = (f32x4){0.f, 0.f, 0.f, 0.f};
    bf16x8 At[4][2], B0[2][2], B1[2][2];
    const char* cA = (const char*)g.A + (size_t)cur.pm * tstep; const char* cB = (const char*)g.Bt + (size_t)cur.pn * tstep;
    S.a_ready(cur);
    PG8_STAGE(PG8_SB(0, 0), cB, voffB); PG8_STAGE(PG8_SA(0, 0), cA, voffA); PG8_STAGE(PG8_SB(0, 1), cB + hstep, voffB); PG8_STAGE(PG8_SA(0, 1), cA + hstep, voffA);
    if (wr == 1) PG8_BAR;
    PG8_WAIT_V(4); PG8_BAR;
    PG8_STAGE(PG8_SB(1, 0), cB + kstep, voffB); PG8_STAGE(PG8_SA(1, 0), cA + kstep, voffA); PG8_STAGE(PG8_SB(1, 1), cB + hstep + kstep, voffB);
    PG8_WAIT_V(6); PG8_BAR;
    PG8_STAMP();
    for (;;) {
        const bool has_next = S.next(ui + 1, nxt);
        const char* nA = has_next ? (const char*)g.A + (size_t)nxt.pm * tstep : cA; const char* nB = has_next ? (const char*)g.Bt + (size_t)nxt.pn * tstep : cB;
        for (int t = 0; t < nt; t += 2) {
            const bool last = (t == nt - 2);
            const char* a1 = cA + (size_t)(t + 1) * kstep;
            const char* a2 = last ? nA : cA + (size_t)(t + 2) * kstep; const char* b2 = last ? nB : cB + (size_t)(t + 2) * kstep;
            const char* a3 = a2 + kstep; const char* b3 = b2 + kstep;
            if (last && has_next) S.a_ready(nxt);
            PG8_LDB(B0, 0, 0); PG8_SCHED; PG8_LDA(At, 0, 0); PG8_STAGE(PG8_SA(1, 1), a1 + hstep, voffA);
            PG8_WAIT_L(8); PG8_BAR; PG8_WAIT_L(0); PG8_MMA(0, 0, At, B0); PG8_BAR; PG8_SCHED;
            PG8_LDB(B1, 0, 1); PG8_STAGE(PG8_SB(0, 0), b2, voffB);
            PG8_BAR; PG8_WAIT_L(0); PG8_MMA(0, 1, At, B1); PG8_BAR;
            PG8_LDA(At, 0, 1); PG8_STAGE(PG8_SA(0, 0), a2, voffA);
            PG8_BAR; PG8_WAIT_L(0); PG8_MMA(1, 0, At, B0); PG8_BAR; PG8_SCHED;
            PG8_STAGE(PG8_SB(0, 1), b2 + hstep, voffB);
            PG8_WAIT_V(6); PG8_BAR; PG8_MMA(1, 1, At, B1); PG8_BAR;
            PG8_LDB(B0, 1, 0); PG8_SCHED; PG8_LDA(At, 1, 0); PG8_STAGE(PG8_SA(0, 1), a2 + hstep, voffA);
            PG8_WAIT_L(8); PG8_BAR; PG8_WAIT_L(0); PG8_MMA(0, 0, At, B0); PG8_BAR; PG8_SCHED;
            PG8_LDB(B1, 1, 1); PG8_STAGE(PG8_SB(1, 0), b3, voffB);
            PG8_BAR; PG8_WAIT_L(0); PG8_MMA(0, 1, At, B1); PG8_BAR;
            PG8_LDA(At, 1, 1); PG8_STAGE(PG8_SA(1, 0), a3, voffA);
            PG8_BAR; PG8_WAIT_L(0); PG8_MMA(1, 0, At, B0); PG8_BAR; PG8_SCHED;
            PG8_STAGE(PG8_SB(1, 1), b3 + hstep, voffB);
            PG8_WAIT_V(6); PG8_BAR; PG8_MMA(1, 1, At, B1); PG8_BAR;
        }
        PG8_STAMP();
        if constexpr (!Epi::AFTER_DRAIN) { E(acc, cur, wr, wc, fr, fq); S.done(cur); }
        PG8_STAMP();
        if (!has_next) break;
#pragma unroll
        for (int a = 0; a < 2; ++a)
#pragma unroll
            for (int b = 0; b < 2; ++b)
#pragma unroll
                for (int m = 0; m < 4; ++m)
#pragma unroll
                    for (int n = 0; n < 2; ++n) acc[a][b][m][n] = (f32x4){0.f, 0.f, 0.f, 0.f};
        cur = nxt; cA = nA; cB = nB; ++ui;
    }
    PG8_WAIT_V(0);
    if (wr == 0) PG8_BAR;
    PG8_BAR;
    if constexpr (Epi::AFTER_DRAIN) { E.fused(acc, cur, wr, wc, fr, fq, lds, wid, lane); S.done(cur); }
    PG8_STAMP();
    if (STAMP && wid == 0) { stamps[lane] = lane < nts ? (((unsigned long long)(unsigned)ts_hi << 32) | (unsigned)ts_lo) : 0ull;
        if (lane == 62) stamps[62] = rt_entry; if (lane == 63) stamps[63] = (unsigned long long)wall_clock64(); }
#undef PG8_STAMP
#undef PG8_SA
#undef PG8_SB
#undef PG8_STAGE
#undef PG8_LDA
#undef PG8_LDB
#undef PG8_MMA
#undef PG8_WAIT_V
#undef PG8_WAIT_L
#undef PG8_BAR
#undef PG8_SCHED
}
}

using pg8::bf16_t; using pg8::f32x4; using pg8::u32x4; using pg8::f32x2; using pg8::u32x2;
using pg8::bf2f; using pg8::bflo; using pg8::bfhi; using pg8::sigmoidf_; using pg8::siluf_; using pg8::cvt_pk_bf16;
#define LAS __attribute__((address_space(3)))
constexpr int SEQ = 2048, MTOK = 8192, DM = 2048, NIN = 20512, NP = 20736, PLE = 256, CONVC = 3072;
constexpr int C_ZSSD = 0, C_XBC = 2048, C_UPOOL = 5120, C_ZPOOL = 7168, C_Q = 9216, C_K = 10752, C_V = 12288, C_ZATTN = 13824, C_GATES = 14336, C_DT = 20480;
constexpr float RMS_EPS = 1e-6f;
constexpr size_t MiB = 1u << 20;
constexpr size_t WS_WT_IN = 0, WT_IN_STRIDE = (size_t)NP * DM;
constexpr size_t WS_WT_BRSSD = 162 * MiB, WS_WT_BRPOOL = 178 * MiB, WS_WT_OUT = 194 * MiB, WS_WT_GATE = 210 * MiB;
constexpr size_t WS_WT_BRATTN = 226 * MiB, WS_WT_POOL = 230 * MiB, WS_WT_PROJ = 234 * MiB, WS_PBF = 236 * MiB;
constexpr size_t WS_H = 244 * MiB, WS_PROJ = 276 * MiB, WS_XBC = 600 * MiB, WS_DT = 648 * MiB, WS_DA = 649 * MiB;
constexpr size_t WS_YRAW = 650 * MiB, WS_YSSD = 682 * MiB, WS_POOLED = 714 * MiB, WS_YPOOL = 746 * MiB;
constexpr size_t WS_QN = 778 * MiB, WS_KN = 802 * MiB, WS_VT = 826 * MiB, WS_YATTN = 850 * MiB;
constexpr size_t WS_MF = 858 * MiB, WS_MB = 922 * MiB, WS_H2 = 954 * MiB, WS_PP = 986 * MiB, WS_END = 1050 * MiB;
constexpr int LDS_BYTES = 147456;

struct Params { const float* in[21]; float* out; unsigned char* ws; };
enum { I_X = 0, I_P, I_NORM_G, I_W_IN, I_CONV_W, I_CONV_B, I_DT_BIAS, I_A_LOG, I_D_SKIP, I_SSD_NORM_G, I_W_BR_SSD, I_POOL_W, I_POOL_SCALE, I_W_BR_POOL,
       I_Q_NORM_G, I_K_NORM_G, I_W_BR_ATTN, I_W_OUT, I_PLE_NORM_G, I_W_PLE_GATE, I_W_PLE_PROJ };

__device__ __forceinline__ float wave_sum(float v) {
#pragma unroll
    for (int o = 1; o < 64; o <<= 1) v += __shfl_xor(v, o);
    return v;
}
#define LDS_WAIT() asm volatile("s_waitcnt lgkmcnt(0)" ::: "memory")

__device__ __forceinline__ void transpose_item(const float* W, int K, int N, bf16_t* WT, int remap, LAS float* scr, int item, int lane) {
    const int nblk = N / 32, kb = item / nblk, nb = item % nblk, k0 = 64 * kb, n0 = 32 * nb;
#pragma unroll 8
    for (int i = 0; i < 32; ++i) { const int kk = 2 * i + (lane >> 5); scr[kk * 33 + (lane & 31)] = W[(size_t)(k0 + kk) * N + n0 + (lane & 31)]; }
    LDS_WAIT(); asm volatile("" ::: "memory");
    int d0 = n0;
    if (remap) d0 = (n0 < 5120) ? n0 : ((n0 < 5152) ? (C_DT + (n0 - 5120)) : (n0 - 32));
    const int c = lane & 7;
#pragma unroll
    for (int j = 0; j < 4; ++j) { const int n = (lane >> 3) + 8 * j; const LAS float* s = scr + (8 * c) * 33 + n;
        u32x4 o; o.x = cvt_pk_bf16(s[0 * 33], s[1 * 33]); o.y = cvt_pk_bf16(s[2 * 33], s[3 * 33]); o.z = cvt_pk_bf16(s[4 * 33], s[5 * 33]); o.w = cvt_pk_bf16(s[6 * 33], s[7 * 33]);
        *(u32x4*)(WT + (size_t)(d0 + n) * K + k0 + 8 * c) = o; }
    LDS_WAIT(); asm volatile("" ::: "memory");
}

__device__ __forceinline__ void rms_row_to_bf16(const float* xrow, const float* g, bf16_t* orow, int lane) {
    f32x4 v[8]; float s = 0.f;
#pragma unroll
    for (int j = 0; j < 8; ++j) { v[j] = *(const f32x4*)(xrow + 256 * j + 4 * lane); s += (v[j][0] * v[j][0] + v[j][1] * v[j][1]) + (v[j][2] * v[j][2] + v[j][3] * v[j][3]); }
    const float rinv = rsqrtf(wave_sum(s) * (1.f / 2048.f) + RMS_EPS);
#pragma unroll
    for (int j = 0; j < 8; ++j) { const f32x4 gg = *(const f32x4*)(g + 256 * j + 4 * lane);
        u32x2 w; w.x = cvt_pk_bf16(v[j][0] * rinv * gg[0], v[j][1] * rinv * gg[1]); w.y = cvt_pk_bf16(v[j][2] * rinv * gg[2], v[j][3] * rinv * gg[3]);
        *(u32x2*)(orow + 256 * j + 4 * lane) = w; }
}

__global__ void __launch_bounds__(512, 2) mega_fwd(Params P) {
    extern __shared__ __attribute__((aligned(16))) unsigned char lds_raw[];
    cg::grid_group grid = cg::this_grid();
    LAS unsigned char* lds = (LAS unsigned char*)lds_raw;
    const int G = gridDim.x, bx = blockIdx.x, NGW = G * 8, NGT = G * 512;
#define PHASE_BEGIN unsigned char* ws = P.ws; asm volatile("" : "+s"(ws)); int tid = threadIdx.x; asm volatile("" : "+v"(tid)); \
    const int lane = tid & 63, wave = __builtin_amdgcn_readfirstlane(tid >> 6), gw = bx * 8 + wave, gt = bx * 512 + tid; (void)lane; (void)gw; (void)gt; (void)ws;
#define WT_IN ((bf16_t*)(ws + WS_WT_IN))
#define WT_BRSSD ((bf16_t*)(ws + WS_WT_BRSSD))
#define WT_BRPOOL ((bf16_t*)(ws + WS_WT_BRPOOL))
#define WT_OUT ((bf16_t*)(ws + WS_WT_OUT))
#define WT_GATE ((bf16_t*)(ws + WS_WT_GATE))
#define WT_BRATTN ((bf16_t*)(ws + WS_WT_BRATTN))
#define WT_POOL ((bf16_t*)(ws + WS_WT_POOL))
#define WT_PROJ ((bf16_t*)(ws + WS_WT_PROJ))
#define PBF ((bf16_t*)(ws + WS_PBF))
#define H ((bf16_t*)(ws + WS_H))
#define PROJ ((bf16_t*)(ws + WS_PROJ))
#define XBC ((bf16_t*)(ws + WS_XBC))
#define DT ((float*)(ws + WS_DT))
#define DA ((float*)(ws + WS_DA))
#define YRAW ((bf16_t*)(ws + WS_YRAW))
#define YSSD ((bf16_t*)(ws + WS_YSSD))
#define POOLED ((bf16_t*)(ws + WS_POOLED))
#define YPOOL ((bf16_t*)(ws + WS_YPOOL))
#define QN ((bf16_t*)(ws + WS_QN))
#define KN ((bf16_t*)(ws + WS_KN))
#define YATTN ((bf16_t*)(ws + WS_YATTN))
#define MF ((float*)(ws + WS_MF))
#define MB ((bf16_t*)(ws + WS_MB))
#define H2 ((bf16_t*)(ws + WS_H2))
#define PP ((float*)(ws + WS_PP))

    { PHASE_BEGIN
        LAS float* scr = (LAS float*)(lds + wave * 16384);
        constexpr int I_IN = 32 * 641, I_SQ = 32 * 64, I_BA = 8 * 64, I_PW = 8 * 16, I_PP = 4 * 64;
        constexpr int I_LAYER = I_IN + 4 * I_SQ + I_BA + 4 * I_PW + I_PP;
        for (int it = gw; it < 2 * I_LAYER; it += NGW) {
            const int L = it / I_LAYER; int r = it - L * I_LAYER;
            if (r < I_IN) { transpose_item(P.in[I_W_IN] + (size_t)L * DM * NIN, DM, NIN, WT_IN + (size_t)L * WT_IN_STRIDE, 1, scr, r, lane); continue; } r -= I_IN;
            if (r < I_SQ) { transpose_item(P.in[I_W_BR_SSD] + (size_t)L * DM * DM, DM, DM, WT_BRSSD + (size_t)L * DM * DM, 0, scr, r, lane); continue; } r -= I_SQ;
            if (r < I_SQ) { transpose_item(P.in[I_W_BR_POOL] + (size_t)L * DM * DM, DM, DM, WT_BRPOOL + (size_t)L * DM * DM, 0, scr, r, lane); continue; } r -= I_SQ;
            if (r < I_SQ) { transpose_item(P.in[I_W_OUT] + (size_t)L * DM * DM, DM, DM, WT_OUT + (size_t)L * DM * DM, 0, scr, r, lane); continue; } r -= I_SQ;
            if (r < I_SQ) { transpose_item(P.in[I_W_PLE_GATE] + (size_t)L * DM * DM, DM, DM, WT_GATE + (size_t)L * DM * DM, 0, scr, r, lane); continue; } r -= I_SQ;
            if (r < I_BA) { transpose_item(P.in[I_W_BR_ATTN] + (size_t)L * 512 * DM, 512, DM, WT_BRATTN + (size_t)L * 512 * DM, 0, scr, r, lane); continue; } r -= I_BA;
            if (r < 4 * I_PW) { const int g = r / I_PW; transpose_item(P.in[I_POOL_W] + (size_t)(L * 4 + g) * 512 * 512, 512, 512, WT_POOL + (size_t)(L * 4 + g) * 512 * 512, 0, scr, r - g * I_PW, lane); continue; } r -= 4 * I_PW;
            transpose_item(P.in[I_W_PLE_PROJ] + (size_t)L * PLE * DM, PLE, DM, WT_PROJ + (size_t)L * PLE * DM, 0, scr, r, lane);
        }
        for (int i = gt; i < 2 * 57344; i += NGT) { const int L = i / 57344, r = i - L * 57344;
            *(u32x4*)(WT_IN + (size_t)L * WT_IN_STRIDE + (size_t)NIN * DM + (size_t)r * 8) = (u32x4){0u, 0u, 0u, 0u}; }
        for (int i = gt; i < 2 * MTOK * PLE / 8; i += NGT) { const f32x4 a = *(const f32x4*)(P.in[I_P] + (size_t)i * 8), b = *(const f32x4*)(P.in[I_P] + (size_t)i * 8 + 4);
            u32x4 w; w.x = cvt_pk_bf16(a[0], a[1]); w.y = cvt_pk_bf16(a[2], a[3]); w.z = cvt_pk_bf16(b[0], b[1]); w.w = cvt_pk_bf16(b[2], b[3]);
            *(u32x4*)(PBF + (size_t)i * 8) = w; }
        for (int m = gw; m < MTOK; m += NGW) rms_row_to_bf16(P.in[I_X] + (size_t)m * DM, P.in[I_NORM_G], H + (size_t)m * DM, lane);
    }
    __syncthreads();
    grid.sync();

#pragma unroll 1
    for (int L = 0; L < 2; ++L) {
        const float* xin = (L == 0) ? P.in[I_X] : P.out;
        { PHASE_BEGIN pg8::Gemm g{H, WT_IN + (size_t)L * WT_IN_STRIDE, MTOK, NP, DM}; pg8::StaticOrder S; S.init(MTOK, NP, G, bx);
          pg8::EpiBf16 E{PROJ, NP}; pg8::gemm_phase<pg8::EpiBf16, pg8::StaticOrder>(lds, g, S, E, nullptr); }
        __syncthreads();
        grid.sync();

        { PHASE_BEGIN
            const float* cw = P.in[I_CONV_W] + (size_t)L * 4 * CONVC; const float* cb = P.in[I_CONV_B] + (size_t)L * CONVC;
            for (int it = gt; it < MTOK * (CONVC / 8); it += NGT) {
                const int m = it / (CONVC / 8), c = (it - m * (CONVC / 8)) * 8, t = m & (SEQ - 1);
                f32x4 a0 = *(const f32x4*)(cb + c), a1 = *(const f32x4*)(cb + c + 4);
#pragma unroll
                for (int k = 0; k < 4; ++k) { const int tt = t - 3 + k;
                    if (tt >= 0) { const u32x4 x = *(const u32x4*)(PROJ + (size_t)(m - 3 + k) * NP + C_XBC + c);
                        const f32x4 w0 = *(const f32x4*)(cw + k * CONVC + c), w1 = *(const f32x4*)(cw + k * CONVC + c + 4);
                        a0[0] += w0[0] * bflo(x.x); a0[1] += w0[1] * bfhi(x.x); a0[2] += w0[2] * bflo(x.y); a0[3] += w0[3] * bfhi(x.y);
                        a1[0] += w1[0] * bflo(x.z); a1[1] += w1[1] * bfhi(x.z); a1[2] += w1[2] * bflo(x.w); a1[3] += w1[3] * bfhi(x.w); } }
                u32x4 w; w.x = cvt_pk_bf16(siluf_(a0[0]), siluf_(a0[1])); w.y = cvt_pk_bf16(siluf_(a0[2]), siluf_(a0[3]));
                w.z = cvt_pk_bf16(siluf_(a1[0]), siluf_(a1[1])); w.w = cvt_pk_bf16(siluf_(a1[2]), siluf_(a1[3]));
                *(u32x4*)(XBC + (size_t)m * CONVC + c) = w;
            }
            for (int it = gt; it < MTOK * 32; it += NGT) { const int m = it >> 5, h = it & 31;
                const float raw = bf2f(PROJ[(size_t)m * NP + C_DT + h]) + P.in[I_DT_BIAS][L * 32 + h];
                const float dt = (raw > 20.f) ? raw : log1pf(__expf(raw));
                DT[it] = dt; DA[it] = -dt * __expf(P.in[I_A_LOG][L * 32 + h]); }
            for (int it = gt; it < MTOK * 256; it += NGT) {
                const int m = it >> 8, c = (it & 255) * 8, t = m & (SEQ - 1), g = c >> 9, w = 2 << g;
                const int cnt = (t + 1 < w) ? (t + 1) : w;
                float s[8];
#pragma unroll
                for (int e = 0; e < 8; ++e) s[e] = 0.f;
                u32x4 x0 = (u32x4){0u, 0u, 0u, 0u};
                for (int j = 0; j < cnt; ++j) { const u32x4 x = *(const u32x4*)(PROJ + (size_t)(m - j) * NP + C_UPOOL + c);
                    if (j == 0) x0 = x;
                    s[0] += bflo(x.x); s[1] += bfhi(x.x); s[2] += bflo(x.y); s[3] += bfhi(x.y); s[4] += bflo(x.z); s[5] += bfhi(x.z); s[6] += bflo(x.w); s[7] += bfhi(x.w); }
                const float ic = 1.f / (float)cnt;
                u32x4 o; o.x = cvt_pk_bf16(s[0] * ic - bflo(x0.x), s[1] * ic - bfhi(x0.x)); o.y = cvt_pk_bf16(s[2] * ic - bflo(x0.y), s[3] * ic - bfhi(x0.y));
                o.z = cvt_pk_bf16(s[4] * ic - bflo(x0.z), s[5] * ic - bfhi(x0.z)); o.w = cvt_pk_bf16(s[6] * ic - bflo(x0.w), s[7] * ic - bfhi(x0.w));
                *(u32x4*)(POOLED + ((size_t)g * MTOK + m) * 512 + (c & 511)) = o;
            }
            for (int it = gw; it < MTOK * 24 / 4; it += NGW) {
                const int rh = it * 4 + (lane >> 4), m = rh / 24, hh = rh - m * 24, isk = hh / 12, head = hh - isk * 12, d = (lane & 15) * 8;
                const u32x4 x = *(const u32x4*)(PROJ + (size_t)m * NP + (isk ? C_K : C_Q) + head * 128 + d);
                float f[8] = {bflo(x.x), bfhi(x.x), bflo(x.y), bfhi(x.y), bflo(x.z), bfhi(x.z), bflo(x.w), bfhi(x.w)};
                float ss = 0.f;
#pragma unroll
                for (int e = 0; e < 8; ++e) ss += f[e] * f[e];
                ss += __shfl_xor(ss, 1); ss += __shfl_xor(ss, 2); ss += __shfl_xor(ss, 4); ss += __shfl_xor(ss, 8);
                const float rinv = rsqrtf(ss * (1.f / 128.f) + RMS_EPS);
                const float* gg = (isk ? P.in[I_K_NORM_G] : P.in[I_Q_NORM_G]) + L * 128 + d;
                const f32x4 g0 = *(const f32x4*)gg, g1 = *(const f32x4*)(gg + 4);
                u32x4 o; o.x = cvt_pk_bf16(f[0] * rinv * g0[0], f[1] * rinv * g0[1]); o.y = cvt_pk_bf16(f[2] * rinv * g0[2], f[3] * rinv * g0[3]);
                o.z = cvt_pk_bf16(f[4] * rinv * g1[0], f[5] * rinv * g1[1]); o.w = cvt_pk_bf16(f[6] * rinv * g1[2], f[7] * rinv * g1[3]);
                *(u32x4*)((isk ? KN : QN) + (size_t)m * 1536 + head * 128 + d) = o;
            }
        }
        __syncthreads();
        grid.sync();

        { PHASE_BEGIN
            for (int item = bx; item < 128; item += G) {
                const int b = item >> 5, h = item & 31, g = h >> 3, p = tid >> 3, nq = tid & 7;
                const float Dh = P.in[I_D_SKIP][L * 32 + h];
                const bf16_t* xp = XBC + (size_t)(b * SEQ) * CONVC + h * 64 + p;
                const bf16_t* Bp = XBC + (size_t)(b * SEQ) * CONVC + 2048 + g * 128 + nq * 16;
                const bf16_t* Cp = Bp + 512;
                const float* dtp = DT + (size_t)(b * SEQ) * 32 + h; const float* dap = DA + (size_t)(b * SEQ) * 32 + h;
                bf16_t* yp = YRAW + (size_t)(b * SEQ) * DM + h * 64 + p;
                float st[16];
#pragma unroll
                for (int i = 0; i < 16; ++i) st[i] = 0.f;
#pragma unroll 2
                for (int t = 0; t < SEQ; ++t) {
                    const float x = bf2f(xp[(size_t)t * CONVC]); const float dt = dtp[t * 32], da = dap[t * 32];
                    const u32x4 b0 = *(const u32x4*)(Bp + (size_t)t * CONVC), b1 = *(const u32x4*)(Bp + (size_t)t * CONVC + 8);
                    const u32x4 c0 = *(const u32x4*)(Cp + (size_t)t * CONVC), c1 = *(const u32x4*)(Cp + (size_t)t * CONVC + 8);
                    const float dec = __expf(da), xd = x * dt;
                    const float bf[16] = {bflo(b0.x), bfhi(b0.x), bflo(b0.y), bfhi(b0.y), bflo(b0.z), bfhi(b0.z), bflo(b0.w), bfhi(b0.w),
                                          bflo(b1.x), bfhi(b1.x), bflo(b1.y), bfhi(b1.y), bflo(b1.z), bfhi(b1.z), bflo(b1.w), bfhi(b1.w)};
                    const float cf[16] = {bflo(c0.x), bfhi(c0.x), bflo(c0.y), bfhi(c0.y), bflo(c0.z), bfhi(c0.z), bflo(c0.w), bfhi(c0.w),
                                          bflo(c1.x), bfhi(c1.x), bflo(c1.y), bfhi(c1.y), bflo(c1.z), bfhi(c1.z), bflo(c1.w), bfhi(c1.w)};
                    float y = 0.f;
#pragma unroll
                    for (int i = 0; i < 16; ++i) { st[i] = dec * st[i] + xd * bf[i]; y += cf[i] * st[i]; }
                    y += __shfl_xor(y, 1); y += __shfl_xor(y, 2); y += __shfl_xor(y, 4);
                    if (nq == 0) { const unsigned w = cvt_pk_bf16(y + Dh * x, 0.f); yp[(size_t)t * DM] = (bf16_t)(w & 0xffffu); }
                }
            }
            for (int it = gw; it < MTOK * 4; it += NGW) {
                const int m = it >> 2, j = it & 3, t = m & (SEQ - 1);
                float mx = -INFINITY, l = 0.f, a0 = 0.f, a1 = 0.f;
                for (int g = 0; g < 3; ++g) {
                    const int dil = 1 << (2 * g), head = g * 4 + j;
                    const unsigned qw = *(const unsigned*)(QN + (size_t)m * 1536 + head * 128 + 2 * lane);
                    const float q0 = bflo(qw), q1 = bfhi(qw);
                    const int tmax = t / dil, nk = (tmax < 128 ? tmax : 128) + 1;
                    for (int i = 0; i < nk; ++i) { const size_t mk = (size_t)(m - i * dil);
                        const unsigned kw = *(const unsigned*)(KN + mk * 1536 + head * 128 + 2 * lane);
                        const unsigned vw = *(const unsigned*)(PROJ + mk * NP + C_V + head * 128 + 2 * lane);
                        const float s = wave_sum(q0 * bflo(kw) + q1 * bfhi(kw)) * 0.08838834764831845f;
                        const float mn = fmaxf(mx, s), al = __expf(mx - mn), pe = __expf(s - mn);
                        l = l * al + pe; a0 = a0 * al + pe * bflo(vw); a1 = a1 * al + pe * bfhi(vw); mx = mn; }
                }
                const unsigned zw = *(const unsigned*)(PROJ + (size_t)m * NP + C_ZATTN + j * 128 + 2 * lane);
                const float il = 1.f / l;
                *(unsigned*)(YATTN + (size_t)m * 512 + j * 128 + 2 * lane) = cvt_pk_bf16(a0 * il * siluf_(bflo(zw)), a1 * il * siluf_(bfhi(zw)));
            }
            __syncthreads();
            { pg8::Gemm g{POOLED, WT_POOL + (size_t)L * 4 * 512 * 512, 4 * MTOK, 2048, 512}; pg8::PoolOrder S{G, bx};
              pg8::EpiPool E{YPOOL, PROJ + C_ZPOOL, NP, P.in[I_POOL_SCALE] + L * 2048};
              pg8::gemm_phase<pg8::EpiPool, pg8::PoolOrder>(lds, g, S, E, nullptr); }
        }
        __syncthreads();
        grid.sync();

        { PHASE_BEGIN
        for (int m = gw; m < MTOK; m += NGW) {
            float v[32]; float ss = 0.f;
#pragma unroll
            for (int j = 0; j < 4; ++j) { const int c = j * 512 + lane * 8;
                const u32x4 y = *(const u32x4*)(YRAW + (size_t)m * DM + c), z = *(const u32x4*)(PROJ + (size_t)m * NP + C_ZSSD + c);
                v[8 * j + 0] = bflo(y.x) * siluf_(bflo(z.x)); v[8 * j + 1] = bfhi(y.x) * siluf_(bfhi(z.x)); v[8 * j + 2] = bflo(y.y) * siluf_(bflo(z.y)); v[8 * j + 3] = bfhi(y.y) * siluf_(bfhi(z.y));
                v[8 * j + 4] = bflo(y.z) * siluf_(bflo(z.z)); v[8 * j + 5] = bfhi(y.z) * siluf_(bfhi(z.z)); v[8 * j + 6] = bflo(y.w) * siluf_(bflo(z.w)); v[8 * j + 7] = bfhi(y.w) * siluf_(bfhi(z.w));
#pragma unroll
                for (int e = 0; e < 8; ++e) ss += v[8 * j + e] * v[8 * j + e]; }
            const float rinv = rsqrtf(wave_sum(ss) * (1.f / 2048.f) + RMS_EPS);
            const float* gg = P.in[I_SSD_NORM_G] + L * DM;
#pragma unroll
            for (int j = 0; j < 4; ++j) { const int c = j * 512 + lane * 8; const f32x4 g0 = *(const f32x4*)(gg + c), g1 = *(const f32x4*)(gg + c + 4);
                u32x4 o; o.x = cvt_pk_bf16(v[8 * j + 0] * rinv * g0[0], v[8 * j + 1] * rinv * g0[1]); o.y = cvt_pk_bf16(v[8 * j + 2] * rinv * g0[2], v[8 * j + 3] * rinv * g0[3]);
                o.z = cvt_pk_bf16(v[8 * j + 4] * rinv * g1[0], v[8 * j + 5] * rinv * g1[1]); o.w = cvt_pk_bf16(v[8 * j + 6] * rinv * g1[2], v[8 * j + 7] * rinv * g1[3]);
                *(u32x4*)(YSSD + (size_t)m * DM + c) = o; }
        } }
        __syncthreads();
        grid.sync();

        { PHASE_BEGIN pg8::StaticOrder S; S.init(MTOK, DM, G, bx);
          { pg8::Gemm g{YSSD, WT_BRSSD + (size_t)L * DM * DM, MTOK, DM, DM}; pg8::EpiMerge<0> E{PROJ + C_GATES, NP, MF, MB};
            pg8::gemm_phase<pg8::EpiMerge<0>, pg8::StaticOrder>(lds, g, S, E, nullptr); }
          { pg8::Gemm g{YPOOL, WT_BRPOOL + (size_t)L * DM * DM, MTOK, DM, DM}; pg8::EpiMerge<1> E{PROJ + C_GATES + 2048, NP, MF, MB};
            pg8::gemm_phase<pg8::EpiMerge<1>, pg8::StaticOrder>(lds, g, S, E, nullptr); }
          { pg8::Gemm g{YATTN, WT_BRATTN + (size_t)L * 512 * DM, MTOK, DM, 512}; pg8::EpiMerge<2> E{PROJ + C_GATES + 4096, NP, MF, MB};
            pg8::gemm_phase<pg8::EpiMerge<2>, pg8::StaticOrder>(lds, g, S, E, nullptr); } }
        __syncthreads();
        grid.sync();

        { PHASE_BEGIN pg8::StaticOrder S; S.init(MTOK, DM, G, bx);
          pg8::Gemm g{MB, WT_OUT + (size_t)L * DM * DM, MTOK, DM, DM}; pg8::EpiResid E{xin, P.out};
          pg8::gemm_phase<pg8::EpiResid, pg8::StaticOrder>(lds, g, S, E, nullptr); }
        __syncthreads();
        grid.sync();

        { PHASE_BEGIN for (int m = gw; m < MTOK; m += NGW) rms_row_to_bf16(P.out + (size_t)m * DM, P.in[I_PLE_NORM_G] + L * DM, H2 + (size_t)m * DM, lane); }
        __syncthreads();
        grid.sync();
        { PHASE_BEGIN pg8::StaticOrder S; S.init(MTOK, DM, G, bx);
          { pg8::Gemm g{PBF + (size_t)L * MTOK * PLE, WT_PROJ + (size_t)L * PLE * DM, MTOK, DM, PLE}; pg8::EpiF32 E{PP, DM};
            pg8::gemm_phase<pg8::EpiF32, pg8::StaticOrder>(lds, g, S, E, nullptr); }
          { pg8::Gemm g{H2, WT_GATE + (size_t)L * DM * DM, MTOK, DM, DM}; pg8::EpiPle E{PP, P.out};
            pg8::gemm_phase<pg8::EpiPle, pg8::StaticOrder>(lds, g, S, E, nullptr); } }
        if (L == 0) {
            __syncthreads();
            grid.sync();
            { PHASE_BEGIN for (int m = gw; m < MTOK; m += NGW) rms_row_to_bf16(P.out + (size_t)m * DM, P.in[I_NORM_G] + DM, H + (size_t)m * DM, lane); }
            __syncthreads();
            grid.sync();
        }
    }
}

extern "C" void kernel_launch(void* const* d_in, const int* in_sizes, int n_in, void* d_out, int out_size, void* d_ws, size_t ws_size, hipStream_t stream) {
    static int grid_blocks = 0;
    if (grid_blocks == 0) {
        if (n_in != 21 || out_size != MTOK * DM || ws_size < WS_END) { fprintf(stderr, "kernel_launch: unexpected shapes: n_in %d out %d ws %zu (need %zu)\n", n_in, out_size, ws_size, (size_t)WS_END); grid_blocks = -1; return; }
        int dev = 0, cus = 0, per_cu = 0;
        hipGetDevice(&dev);
        hipDeviceGetAttribute(&cus, hipDeviceAttributeMultiprocessorCount, dev);
        if (hipFuncSetAttribute((const void*)mega_fwd, hipFuncAttributeMaxDynamicSharedMemorySize, LDS_BYTES) != hipSuccess) { fprintf(stderr, "kernel_launch: hipFuncSetAttribute failed\n"); grid_blocks = -1; return; }
        if (hipOccupancyMaxActiveBlocksPerMultiprocessor(&per_cu, (const void*)mega_fwd, 512, LDS_BYTES) != hipSuccess || per_cu < 1) { fprintf(stderr, "kernel_launch: occupancy query gave %d\n", per_cu); per_cu = 1; (void)hipGetLastError(); }
        grid_blocks = cus * (per_cu > 1 ? 1 : per_cu);
    }
    if (grid_blocks < 0) return;
    Params p{};
    for (int i = 0; i < 21; ++i) p.in[i] = (const float*)d_in[i];
    p.out = (float*)d_out; p.ws = (unsigned char*)d_ws;
    void* args[] = {&p};
    hipError_t e = hipLaunchCooperativeKernel((const void*)mega_fwd, dim3(grid_blocks), dim3(512), args, LDS_BYTES, stream);
    if (e != hipSuccess) fprintf(stderr, "cooperative launch failed: %s (grid %d)\n", hipGetErrorString(e), grid_blocks);
}
```

```cpp
#include <hip/hip_runtime.h>
#include <hip/hip_cooperative_groups.h>
#include <cstdio>
namespace cg = cooperative_groups;
namespace pg8 {
#define PG8_LAS __attribute__((address_space(3)))
typedef unsigned short bf16_t;
typedef short bf16x8 __attribute__((ext_vector_type(8)));
typedef float f32x4 __attribute__((ext_vector_type(4)));
typedef unsigned u32x4 __attribute__((ext_vector_type(4)));
constexpr int BM = 256, BK = 64, HALF = 128, HTB = HALF * BK * 2  , STAGE_BYTES = 8 * HTB, NXCD = 8, WGM = 8;

__host__ __device__ __forceinline__ int lds_byte(int r, int c) { const int st = (r >> 4) * 2 + (c >> 5), rr = r & 15, cc = c & 31, ob = rr * 64 + cc * 2; return st * 1024 + (ob ^ (((ob >> 9) & 1) << 5)); }
__host__ __device__ __forceinline__ void stage_rc(int b, int& R, int& C) { const int st = b / 1024, sb = b % 1024, swz = sb ^ (((sb >> 9) & 1) << 5); R = (st >> 1) * 16 + swz / 64; C = (st & 1) * 32 + (swz % 64) / 2; }
__host__ __device__ __forceinline__ int perm32(int rho) { const int n = rho >> 4, i = rho & 15; return 8 * (i >> 2) + 4 * n + (i & 3); }

struct Unit { int pm, pn; };
struct Gemm { const bf16_t* A; const bf16_t* Bt; int M, N, K; };

struct StaticOrder {
    int nM, nN, nwg, G, c;
    __host__ __device__ void init(int M, int N, int G_, int c_) { nM = M / BM; nN = N / BM; nwg = nM * nN; G = G_; c = c_; }
    __host__ __device__ bool next(int i, Unit& u) const {
        const long L = (long)i * G + c; if (L >= nwg) return false;
        int wgid = (int)L; { const int q = nwg / NXCD, r = nwg % NXCD, xcd = wgid % NXCD, off = wgid / NXCD; wgid = (xcd < r ? xcd * (q + 1) : r * (q + 1) + (xcd - r) * q) + off; }
        const int nig = WGM * nN, gid = wgid / nig, fm = gid * WGM, gsz = (nM - fm) < WGM ? (nM - fm) : WGM;
        u.pm = fm + ((wgid % nig) % gsz); u.pn = (wgid % nig) / gsz; return true;
    }
    __device__ __forceinline__ void a_ready(const Unit&) const {}
    __device__ __forceinline__ void done(const Unit&) const {}
};
__device__ __forceinline__ unsigned cvt_pk_bf16(float lo, float hi) { unsigned r; asm volatile("v_cvt_pk_bf16_f32 %0, %1, %2" : "=v"(r) : "v"(lo), "v"(hi)); return r; }
typedef float f32x2 __attribute__((ext_vector_type(2)));
typedef unsigned u32x2 __attribute__((ext_vector_type(2)));
__device__ __forceinline__ float bf2f(unsigned short b) { return __uint_as_float(((unsigned)b) << 16); }
__device__ __forceinline__ float bflo(unsigned w) { return __uint_as_float(w << 16); }
__device__ __forceinline__ float bfhi(unsigned w) { return __uint_as_float(w & 0xffff0000u); }
__device__ __forceinline__ float sigmoidf_(float x) { return __builtin_amdgcn_rcpf(1.0f + __expf(-x)); }
__device__ __forceinline__ float siluf_(float x) { return x * __builtin_amdgcn_rcpf(1.0f + __expf(-x)); }

struct EpiF32 {
    static constexpr bool PERM = false, AFTER_DRAIN = false;
    float* C; int ldc;
    __device__ __forceinline__ void operator()(const f32x4 (&acc)[2][2][4][2], const Unit& u, int wr, int wc, int fr, int fq) const {
        const int row0 = u.pm * BM + wr * 64 + fr, col0 = u.pn * BM + wc * 32 + 4 * fq;
#pragma unroll
        for (int ai = 0; ai < 2; ++ai)
#pragma unroll
            for (int m = 0; m < 4; ++m) { float* rowp = C + (size_t)(row0 + ai * HALF + m * 16) * ldc + col0;
#pragma unroll
                for (int bj = 0; bj < 2; ++bj)
#pragma unroll
                    for (int n = 0; n < 2; ++n) *(f32x4*)(rowp + bj * HALF + n * 16) = acc[ai][bj][m][n]; }
    }
};
struct EpiBf16 {
    static constexpr bool PERM = true, AFTER_DRAIN = false;
    bf16_t* O; int ldc; const float* SS;
    __device__ __forceinline__ void operator()(const f32x4 (&acc)[2][2][4][2], const Unit& u, int wr, int wc, int fr, int fq) const {
        const int row0 = u.pm * BM + wr * 64 + fr; const int col0 = u.pn * BM + wc * 32 + 8 * fq;
#pragma unroll
        for (int ai = 0; ai < 2; ++ai)
#pragma unroll
            for (int m = 0; m < 4; ++m) { const int row = row0 + ai * HALF + m * 16; bf16_t* rowp = O + (size_t)row * ldc + col0;
                const float ri = rsqrtf(SS[row] * (1.f / 2048.f) + 1e-6f);
#pragma unroll
                for (int bj = 0; bj < 2; ++bj) { const f32x4 v0 = acc[ai][bj][m][0] * ri, v1 = acc[ai][bj][m][1] * ri;
                    u32x4 w; w.x = cvt_pk_bf16(v0[0], v0[1]); w.y = cvt_pk_bf16(v0[2], v0[3]); w.z = cvt_pk_bf16(v1[0], v1[1]); w.w = cvt_pk_bf16(v1[2], v1[3]);
                    *(u32x4*)(rowp + bj * HALF) = w; } }
    }
};
struct EpiBf16NP {
    static constexpr bool PERM = false, AFTER_DRAIN = false;
    bf16_t* O;
    __device__ __forceinline__ void operator()(const f32x4 (&acc)[2][2][4][2], const Unit& u, int wr, int wc, int fr, int fq) const {
        const int row0 = u.pm * BM + wr * 64 + fr, col0 = u.pn * BM + wc * 32 + 4 * fq;
#pragma unroll
        for (int ai = 0; ai < 2; ++ai)
#pragma unroll
            for (int m = 0; m < 4; ++m) { const size_t row = (size_t)(row0 + ai * HALF + m * 16);
#pragma unroll
                for (int bj = 0; bj < 2; ++bj)
#pragma unroll
                    for (int n = 0; n < 2; ++n) { const f32x4 v = acc[ai][bj][m][n]; u32x2 w; w.x = cvt_pk_bf16(v[0], v[1]); w.y = cvt_pk_bf16(v[2], v[3]);
                        *(u32x2*)(O + row * 2048 + col0 + bj * HALF + n * 16) = w; } }
    }
};
struct EpiPool {
    static constexpr bool PERM = true, AFTER_DRAIN = false;
    bf16_t* O; const bf16_t* Z; int ldz; const float* scale;
    __device__ __forceinline__ void operator()(const f32x4 (&acc)[2][2][4][2], const Unit& u, int wr, int wc, int fr, int fq) const {
        const int row0 = (u.pm & 31) * BM + wr * 64 + fr; const int col0 = u.pn * BM + wc * 32 + 8 * fq;
#pragma unroll
        for (int bj = 0; bj < 2; ++bj) {
            const f32x4 s0 = *(const f32x4*)(scale + col0 + bj * HALF), s1 = *(const f32x4*)(scale + col0 + bj * HALF + 4);
#pragma unroll
            for (int ai = 0; ai < 2; ++ai)
#pragma unroll
                for (int m = 0; m < 4; ++m) { const size_t row = (size_t)(row0 + ai * HALF + m * 16);
                    const u32x4 z = *(const u32x4*)(Z + row * ldz + col0 + bj * HALF);
                    const f32x4 v0 = acc[ai][bj][m][0], v1 = acc[ai][bj][m][1];
                    u32x4 w;
                    w.x = cvt_pk_bf16(v0[0] * s0[0] * siluf_(bflo(z.x)), v0[1] * s0[1] * siluf_(bfhi(z.x)));
                    w.y = cvt_pk_bf16(v0[2] * s0[2] * siluf_(bflo(z.y)), v0[3] * s0[3] * siluf_(bfhi(z.y)));
                    w.z = cvt_pk_bf16(v1[0] * s1[0] * siluf_(bflo(z.z)), v1[1] * s1[1] * siluf_(bfhi(z.z)));
                    w.w = cvt_pk_bf16(v1[2] * s1[2] * siluf_(bflo(z.w)), v1[3] * s1[3] * siluf_(bfhi(z.w)));
                    *(u32x4*)(O + row * 2048 + col0 + bj * HALF) = w; } }
    }
};
template <int MODE> struct EpiMerge {
    static constexpr bool PERM = false, AFTER_DRAIN = false;
    const bf16_t* GL; int ldg; float* MF; bf16_t* MB;
    __device__ __forceinline__ void operator()(const f32x4 (&acc)[2][2][4][2], const Unit& u, int wr, int wc, int fr, int fq) const {
        const int row0 = u.pm * BM + wr * 64 + fr, col0 = u.pn * BM + wc * 32 + 4 * fq;
#pragma unroll
        for (int ai = 0; ai < 2; ++ai)
#pragma unroll
            for (int m = 0; m < 4; ++m) { const size_t row = (size_t)(row0 + ai * HALF + m * 16);
#pragma unroll
                for (int bj = 0; bj < 2; ++bj)
#pragma unroll
                    for (int n = 0; n < 2; ++n) { const int col = col0 + bj * HALF + n * 16;
                        const u32x2 g = *(const u32x2*)(GL + row * ldg + col);
                        f32x4 v = acc[ai][bj][m][n];
                        v[0] *= sigmoidf_(bflo(g.x)); v[1] *= sigmoidf_(bfhi(g.x)); v[2] *= sigmoidf_(bflo(g.y)); v[3] *= sigmoidf_(bfhi(g.y));
                        if (MODE >= 1) v += *(const f32x4*)(MF + row * 2048 + col);
                        if (MODE < 2) *(f32x4*)(MF + row * 2048 + col) = v;
                        else { u32x2 w; w.x = cvt_pk_bf16(v[0], v[1]); w.y = cvt_pk_bf16(v[2], v[3]); *(u32x2*)(MB + row * 2048 + col) = w; } } }
    }
};
template <bool XBF> struct EpiResid {
    static constexpr bool PERM = false, AFTER_DRAIN = false;
    const float* XIN; const bf16_t* XINB; bf16_t* XB; float* SSo;
    __device__ __forceinline__ void operator()(const f32x4 (&acc)[2][2][4][2], const Unit& u, int wr, int wc, int fr, int fq) const {
        const int row0 = u.pm * BM + wr * 64 + fr, col0 = u.pn * BM + wc * 32 + 4 * fq;
#pragma unroll
        for (int ai = 0; ai < 2; ++ai)
#pragma unroll
            for (int m = 0; m < 4; ++m) { const size_t row = (size_t)(row0 + ai * HALF + m * 16); float ss = 0.f;
#pragma unroll
                for (int bj = 0; bj < 2; ++bj)
#pragma unroll
                    for (int n = 0; n < 2; ++n) { const size_t idx = row * 2048 + col0 + bj * HALF + n * 16;
                        f32x4 xi;
                        if (XBF) { const u32x2 xw = *(const u32x2*)(XINB + idx); xi = (f32x4){bflo(xw.x), bfhi(xw.x), bflo(xw.y), bfhi(xw.y)}; } else xi = *(const f32x4*)(XIN + idx);
                        const f32x4 o = xi + acc[ai][bj][m][n];
                        u32x2 w; w.x = cvt_pk_bf16(o[0], o[1]); w.y = cvt_pk_bf16(o[2], o[3]); *(u32x2*)(XB + idx) = w;
                        const float r0 = bflo(w.x), r1 = bfhi(w.x), r2 = bflo(w.y), r3 = bfhi(w.y);
                        ss += (r0 * r0 + r1 * r1) + (r2 * r2 + r3 * r3); }
                ss += __shfl_xor(ss, 16); ss += __shfl_xor(ss, 32);
                if (fq == 0) unsafeAtomicAdd(SSo + row, ss); }
    }
};
template <bool NEXT> struct EpiPle {
    static constexpr bool PERM = false, AFTER_DRAIN = false;
    const bf16_t* PP; const bf16_t* X1B; float* OUT; const float* SSi; bf16_t* XB; float* SSo;
    __device__ __forceinline__ void operator()(const f32x4 (&acc)[2][2][4][2], const Unit& u, int wr, int wc, int fr, int fq) const {
        const int row0 = u.pm * BM + wr * 64 + fr, col0 = u.pn * BM + wc * 32 + 4 * fq;
#pragma unroll
        for (int ai = 0; ai < 2; ++ai)
#pragma unroll
            for (int m = 0; m < 4; ++m) { const size_t row = (size_t)(row0 + ai * HALF + m * 16); float ss = 0.f;
                const float ri = rsqrtf(SSi[row] * (1.f / 2048.f) + 1e-6f);
#pragma unroll
                for (int bj = 0; bj < 2; ++bj)
#pragma unroll
                    for (int n = 0; n < 2; ++n) { const size_t idx = row * 2048 + col0 + bj * HALF + n * 16;
                        const f32x4 a = acc[ai][bj][m][n] * ri; const u32x2 pw = *(const u32x2*)(PP + idx); const f32x4 pp = {bflo(pw.x), bfhi(pw.x), bflo(pw.y), bfhi(pw.y)}; const u32x2 xw = *(const u32x2*)(X1B + idx);
                        f32x4 o = {bflo(xw.x), bfhi(xw.x), bflo(xw.y), bfhi(xw.y)};
                        o[0] += sigmoidf_(a[0]) * pp[0]; o[1] += sigmoidf_(a[1]) * pp[1]; o[2] += sigmoidf_(a[2]) * pp[2]; o[3] += sigmoidf_(a[3]) * pp[3];
                        if (NEXT) { u32x2 w; w.x = cvt_pk_bf16(o[0], o[1]); w.y = cvt_pk_bf16(o[2], o[3]); *(u32x2*)(XB + idx) = w;
                            const float r0 = bflo(w.x), r1 = bfhi(w.x), r2 = bflo(w.y), r3 = bfhi(w.y);
                            ss += (r0 * r0 + r1 * r1) + (r2 * r2 + r3 * r3); }
                        else *(f32x4*)(OUT + idx) = o; }
                if (NEXT) { ss += __shfl_xor(ss, 16); ss += __shfl_xor(ss, 32); if (fq == 0) unsafeAtomicAdd(SSo + row, ss); } }
    }
};
struct PoolOrder {
    int G, c;
    __device__ bool next(int i, Unit& u) const {
        const int L = i * G + c; if (L >= 256) return false;
        const int g = L >> 6, rem = L & 63, mt = rem >> 1, nt = rem & 1;
        u.pm = g * 32 + mt; u.pn = g * 2 + nt; return true;
    }
    __device__ __forceinline__ void a_ready(const Unit&) const {}
    __device__ __forceinline__ void done(const Unit&) const {}
};
template <class Epi, class Sched, bool STAMP = false>
__device__ __forceinline__ void gemm_phase(PG8_LAS unsigned char* lds, const Gemm g, const Sched& S, const Epi& E, unsigned long long* stamps) {
    int tid_ = threadIdx.x; asm volatile("" : "+v"(tid_));
    const int tid = tid_, wid = __builtin_amdgcn_readfirstlane(tid >> 6), lane = tid & 63, wr = wid >> 2, wc = wid & 3, fr = lane & 15, fq = lane >> 4;
    const int K = g.K, nt = K / BK;
    int ts_lo = 0, ts_hi = 0, nts = 0; const unsigned long long rt_entry = STAMP ? (unsigned long long)wall_clock64() : 0ull;
#define PG8_STAMP() do { if (STAMP && wid == 0 && nts < 64) { const unsigned long long _c = (unsigned long long)clock64(); \
        ts_lo = (lane == nts) ? (int)(unsigned)_c : ts_lo; ts_hi = (lane == nts) ? (int)(unsigned)(_c >> 32) : ts_hi; ++nts; } } while (0)
    PG8_STAMP();
    unsigned voffA[2], voffB[2];
#pragma unroll
    for (int i = 0; i < 2; ++i) { int R, C; stage_rc(tid * 16 + i * 8192, R, C); const int Rb = Epi::PERM ? ((R & ~31) + perm32(R & 31)) : R;
        voffA[i] = (unsigned)(R * K + C) * 2u; voffB[i] = (unsigned)(Rb * K + C) * 2u; }
    const size_t kstep = (size_t)(BK * 2);
    const size_t hstep = (size_t)HALF * K * 2;
    const size_t tstep = 2 * hstep;
    const unsigned ldsw = (unsigned)wid * 1024u;
    const int aoff = lds_byte(wr * 64 + fr, fq * 8), boff = lds_byte(wc * 32 + fr, fq * 8);
#define PG8_SA(b, h) (((b) * 2 + (h)) * HTB)
#define PG8_SB(b, h) ((4 + (b) * 2 + (h)) * HTB)
#define PG8_STAGE(bufoff, gbase, voff) do { _Pragma("unroll") for (int _i = 0; _i < 2; ++_i) \
        __builtin_amdgcn_global_load_lds((const unsigned*)((const char*)(gbase) + (voff)[_i]), (PG8_LAS unsigned*)(lds + (bufoff) + ldsw + _i * 8192), 16, 0, 0); } while (0)
#define PG8_LDA(dst, b, h) do { _Pragma("unroll") for (int m = 0; m < 4; ++m) _Pragma("unroll") for (int k = 0; k < 2; ++k) dst[m][k] = *(const PG8_LAS bf16x8*)(lds + PG8_SA(b, h) + aoff + m * 2048 + k * 1024); } while (0)
#define PG8_LDB(dst, b, h) do { _Pragma("unroll") for (int n = 0; n < 2; ++n) _Pragma("unroll") for (int k = 0; k < 2; ++k) dst[n][k] = *(const PG8_LAS bf16x8*)(lds + PG8_SB(b, h) + boff + n * 2048 + k * 1024); } while (0)
#define PG8_MMA(ai, bj, At, Bt) do { __builtin_amdgcn_s_setprio(1); _Pragma("unroll") for (int m = 0; m < 4; ++m) _Pragma("unroll") for (int n = 0; n < 2; ++n) _Pragma("unroll") for (int k = 0; k < 2; ++k) \
        acc[ai][bj][m][n] = __builtin_amdgcn_mfma_f32_16x16x32_bf16(Bt[n][k], At[m][k], acc[ai][bj][m][n], 0, 0, 0); __builtin_amdgcn_s_setprio(0); } while (0)
#define PG8_WAIT_V(n) asm volatile("s_waitcnt vmcnt(" #n ")" ::: "memory")
#define PG8_WAIT_L(n) asm volatile("s_waitcnt lgkmcnt(" #n ")" ::: "memory")
#define PG8_BAR __builtin_amdgcn_s_barrier()
#define PG8_SCHED __builtin_amdgcn_sched_barrier(0)
    Unit cur, nxt; int ui = 0;
    if (!S.next(0, cur)) return;
    f32x4 acc[2][2][4][2];
#pragma unroll
    for (int a = 0; a < 2; ++a)
#pragma unroll
        for (int b = 0; b < 2; ++b)
#pragma unroll
            for (int m = 0; m < 4; ++m)
#pragma unroll
                for (int n = 0; n < 2; ++n) acc[a][b][m][n] = (f32x4){0.f, 0.f, 0.f, 0.f};
    bf16x8 At[4][2], B0[2][2], B1[2][2];
    const char* cA = (const char*)g.A + (size_t)cur.pm * tstep; const char* cB = (const char*)g.Bt + (size_t)cur.pn * tstep;
    S.a_ready(cur);
    PG8_STAGE(PG8_SB(0, 0), cB, voffB); PG8_STAGE(PG8_SA(0, 0), cA, voffA); PG8_STAGE(PG8_SB(0, 1), cB + hstep, voffB); PG8_STAGE(PG8_SA(0, 1), cA + hstep, voffA);
    if (wr == 1) PG8_BAR;
    PG8_WAIT_V(4); PG8_BAR;
    PG8_STAGE(PG8_SB(1, 0), cB + kstep, voffB); PG8_STAGE(PG8_SA(1, 0), cA + kstep, voffA); PG8_STAGE(PG8_SB(1, 1), cB + hstep + kstep, voffB);
    PG8_WAIT_V(6); PG8_BAR;
    PG8_STAMP();
    for (;;) {
        const bool has_next = S.next(ui + 1, nxt);
        const char* nA = has_next ? (const char*)g.A + (size_t)nxt.pm * tstep : cA; const char* nB = has_next ? (const char*)g.Bt + (size_t)nxt.pn * tstep : cB;
        for (int t = 0; t < nt; t += 2) {
            const bool last = (t == nt - 2);
            const char* a1 = cA + (size_t)(t + 1) * kstep;
            const char* a2 = last ? nA : cA + (size_t)(t + 2) * kstep; const char* b2 = last ? nB : cB + (size_t)(t + 2) * kstep;
            const char* a3 = a2 + kstep; const char* b3 = b2 + kstep;
            if (last && has_next) S.a_ready(nxt);
            PG8_LDB(B0, 0, 0); PG8_SCHED; PG8_LDA(At, 0, 0); PG8_STAGE(PG8_SA(1, 1), a1 + hstep, voffA);
            PG8_WAIT_L(8); PG8_BAR; PG8_WAIT_L(0); PG8_MMA(0, 0, At, B0); PG8_BAR; PG8_SCHED;
            PG8_LDB(B1, 0, 1); PG8_STAGE(PG8_SB(0, 0), b2, voffB);
            PG8_BAR; PG8_WAIT_L(0); PG8_MMA(0, 1, At, B1); PG8_BAR;
            PG8_LDA(At, 0, 1); PG8_STAGE(PG8_SA(0, 0), a2, voffA);
            PG8_BAR; PG8_WAIT_L(0); PG8_MMA(1, 0, At, B0); PG8_BAR; PG8_SCHED;
            PG8_STAGE(PG8_SB(0, 1), b2 + hstep, voffB);
            PG8_WAIT_V(6); PG8_BAR; PG8_MMA(1, 1, At, B1); PG8_BAR;
            PG8_LDB(B0, 1, 0); PG8_SCHED; PG8_LDA(At, 1, 0); PG8_STAGE(PG8_SA(0, 1), a2 + hstep, voffA);
            PG8_WAIT_L(8); PG8_BAR; PG8_WAIT_L(0); PG8_MMA(0, 0, At, B0); PG8_BAR; PG8_SCHED;
            PG8_LDB(B1, 1, 1); PG8_STAGE(PG8_SB(1, 0), b3, voffB);
            PG8_BAR; PG8_WAIT_L(0); PG8_MMA(0, 1, At, B1); PG8_BAR;
            PG8_LDA(At, 1, 1); PG8_STAGE(PG8_SA(1, 0), a3, voffA);
            PG8_BAR; PG8_WAIT_L(0); PG8_MMA(1, 0, At, B0); PG8_BAR; PG8_SCHED;
            PG8_STAGE(PG8_SB(1, 1), b3 + hstep, voffB);
            PG8_WAIT_V(6); PG8_BAR; PG8_MMA(1, 1, At, B1); PG8_BAR;
        }
        PG8_STAMP();
        if constexpr (!Epi::AFTER_DRAIN) { E(acc, cur, wr, wc, fr, fq); S.done(cur); }
        PG8_STAMP();
        if (!has_next) break;
#pragma unroll
        for (int a = 0; a < 2; ++a)
#pragma unroll
            for (int b = 0; b < 2; ++b)
#pragma unroll
                for (int m = 0; m < 4; ++m)
#pragma unroll
                    for (int n = 0; n < 2; ++n) acc[a][b][m][n] = (f32x4){0.f, 0.f, 0.f, 0.f};
        cur = nxt; cA = nA; cB = nB; ++ui;
    }
    PG8_WAIT_V(0);
    if (wr == 0) PG8_BAR;
    PG8_BAR;
    if constexpr (Epi::AFTER_DRAIN) { E.fused(acc, cur, wr, wc, fr, fq, lds, wid, lane); S.done(cur); }
    PG8_STAMP();
    if (STAMP && wid == 0) { stamps[lane] = lane < nts ? (((unsigned long long)(unsigned)ts_hi << 32) | (unsigned)ts_lo) : 0ull;
        if (lane == 62) stamps[62] = rt_entry; if (lane == 63) stamps[63] = (unsigned long long)wall_clock64(); }
#undef PG8_STAMP
#undef PG8_SA
#undef PG8_SB
#undef PG8_STAGE
#undef PG8_LDA
#undef PG8_LDB
#undef PG8_MMA
#undef PG8_WAIT_V
#undef PG8_WAIT_L
#undef PG8_BAR
#undef PG8_SCHED
}
struct Merge3 { const bf16_t* A0; const bf16_t* A1; const bf16_t* A2; const bf16_t* B0; const bf16_t* B1; const bf16_t* B2; int K0, K1, K2; const bf16_t* GL; int ldg; bf16_t* MB; const float* SSY; };
template <class Sched>
__device__ __forceinline__ void gemm_merge3(PG8_LAS unsigned char* lds, const Merge3 g, const Sched& S) {
    constexpr bool STAMP = false; unsigned long long* stamps = nullptr;
    int tid_ = threadIdx.x; asm volatile("" : "+v"(tid_));
    const int tid = tid_, wid = __builtin_amdgcn_readfirstlane(tid >> 6), lane = tid & 63, wr = wid >> 2, wc = wid & 3, fr = lane & 15, fq = lane >> 4;
    int Kc = g.K0, nt = Kc / BK;
    int ts_lo = 0, ts_hi = 0, nts = 0; const unsigned long long rt_entry = STAMP ? (unsigned long long)wall_clock64() : 0ull;
#define PG8_STAMP() do { if (STAMP && wid == 0 && nts < 64) { const unsigned long long _c = (unsigned long long)clock64(); \
        ts_lo = (lane == nts) ? (int)(unsigned)_c : ts_lo; ts_hi = (lane == nts) ? (int)(unsigned)(_c >> 32) : ts_hi; ++nts; } } while (0)
    PG8_STAMP();
    unsigned voffA[2], voffB[2], voffAn[2], voffBn[2]; int Rr[2], Rbr[2], Cc[2];
#pragma unroll
    for (int i = 0; i < 2; ++i) { int R, C; stage_rc(tid * 16 + i * 8192, R, C); Rr[i] = R; Rbr[i] = (R & ~31) + perm32(R & 31); Cc[i] = C;
        voffA[i] = (unsigned)(R * Kc + C) * 2u; voffB[i] = (unsigned)(Rbr[i] * Kc + C) * 2u; voffAn[i] = voffA[i]; voffBn[i] = voffB[i]; }
    const size_t kstep = (size_t)(BK * 2);
    size_t hstep = (size_t)HALF * Kc * 2, hstepn = hstep;
    const unsigned ldsw = (unsigned)wid * 1024u;
    const int aoff = lds_byte(wr * 64 + fr, fq * 8), boff = lds_byte(wc * 32 + fr, fq * 8);
#define PG8_SA(b, h) (((b) * 2 + (h)) * HTB)
#define PG8_SB(b, h) ((4 + (b) * 2 + (h)) * HTB)
#define PG8_STAGE(bufoff, gbase, voff) do { _Pragma("unroll") for (int _i = 0; _i < 2; ++_i) \
        __builtin_amdgcn_global_load_lds((const unsigned*)((const char*)(gbase) + (voff)[_i]), (PG8_LAS unsigned*)(lds + (bufoff) + ldsw + _i * 8192), 16, 0, 0); } while (0)
#define PG8_LDA(dst, b, h) do { _Pragma("unroll") for (int m = 0; m < 4; ++m) _Pragma("unroll") for (int k = 0; k < 2; ++k) dst[m][k] = *(const PG8_LAS bf16x8*)(lds + PG8_SA(b, h) + aoff + m * 2048 + k * 1024); } while (0)
#define PG8_LDB(dst, b, h) do { _Pragma("unroll") for (int n = 0; n < 2; ++n) _Pragma("unroll") for (int k = 0; k < 2; ++k) dst[n][k] = *(const PG8_LAS bf16x8*)(lds + PG8_SB(b, h) + boff + n * 2048 + k * 1024); } while (0)
#define PG8_MMA(ai, bj, At, Bt) do { __builtin_amdgcn_s_setprio(1); _Pragma("unroll") for (int m = 0; m < 4; ++m) _Pragma("unroll") for (int n = 0; n < 2; ++n) _Pragma("unroll") for (int k = 0; k < 2; ++k) \
        acc[ai][bj][m][n] = __builtin_amdgcn_mfma_f32_16x16x32_bf16(Bt[n][k], At[m][k], acc[ai][bj][m][n], 0, 0, 0); __builtin_amdgcn_s_setprio(0); } while (0)
#define PG8_WAIT_V(n) asm volatile("s_waitcnt vmcnt(" #n ")" ::: "memory")
#define PG8_WAIT_L(n) asm volatile("s_waitcnt lgkmcnt(" #n ")" ::: "memory")
#define PG8_BAR __builtin_amdgcn_s_barrier()
#define PG8_SCHED __builtin_amdgcn_sched_barrier(0)
    Unit cur, nxt; int ui = 0, sub = 0;
    if (!S.next(0, cur)) return;
    f32x4 acc[2][2][4][2];
#pragma unroll
    for (int a = 0; a < 2; ++a)
#pragma unroll
        for (int b = 0; b < 2; ++b)
#pragma unroll
            for (int m = 0; m < 4; ++m)
#pragma unroll
                for (int n = 0; n < 2; ++n) acc[a][b][m][n] = (f32x4){0.f, 0.f, 0.f, 0.f};
    bf16x8 At[4][2], B0[2][2], B1[2][2];
    const char* cA = (const char*)g.A0 + (size_t)cur.pm * 2 * hstep; const char* cB = (const char*)g.B0 + (size_t)cur.pn * 2 * hstep;
    S.a_ready(cur);
    PG8_STAGE(PG8_SB(0, 0), cB, voffB); PG8_STAGE(PG8_SA(0, 0), cA, voffA); PG8_STAGE(PG8_SB(0, 1), cB + hstep, voffB); PG8_STAGE(PG8_SA(0, 1), cA + hstep, voffA);
    if (wr == 1) PG8_BAR;
    PG8_WAIT_V(4); PG8_BAR;
    PG8_STAGE(PG8_SB(1, 0), cB + kstep, voffB); PG8_STAGE(PG8_SA(1, 0), cA + kstep, voffA); PG8_STAGE(PG8_SB(1, 1), cB + hstep + kstep, voffB);
    PG8_WAIT_V(6); PG8_BAR;
    PG8_STAMP();
    for (;;) {
        const int subn = (sub == 2) ? 0 : sub + 1; bool has_next = true; nxt = cur;
        if (sub == 2) has_next = S.next(ui + 1, nxt);
        const int Kn = has_next ? ((subn == 0) ? g.K0 : ((subn == 1) ? g.K1 : g.K2)) : Kc;
        hstepn = (size_t)HALF * Kn * 2;
#pragma unroll
        for (int i = 0; i < 2; ++i) { voffAn[i] = (unsigned)(Rr[i] * Kn + Cc[i]) * 2u; voffBn[i] = (unsigned)(Rbr[i] * Kn + Cc[i]) * 2u; }
        const bf16_t* An_ = (subn == 0) ? g.A0 : ((subn == 1) ? g.A1 : g.A2); const bf16_t* Bn_ = (subn == 0) ? g.B0 : ((subn == 1) ? g.B1 : g.B2);
        const char* nA = has_next ? (const char*)An_ + (size_t)nxt.pm * 2 * hstepn : cA; const char* nB = has_next ? (const char*)Bn_ + (size_t)nxt.pn * 2 * hstepn : cB;
        for (int t = 0; t < nt; t += 2) {
            const bool last = (t == nt - 2);
            const char* a1 = cA + (size_t)(t + 1) * kstep;
            const char* a2 = last ? nA : cA + (size_t)(t + 2) * kstep; const char* b2 = last ? nB : cB + (size_t)(t + 2) * kstep;
            const char* a3 = a2 + kstep; const char* b3 = b2 + kstep;
            unsigned vA2[2], vB2[2];
#pragma unroll
            for (int i = 0; i < 2; ++i) { vA2[i] = last ? voffAn[i] : voffA[i]; vB2[i] = last ? voffBn[i] : voffB[i]; }
            const size_t h2 = last ? hstepn : hstep;
            PG8_LDB(B0, 0, 0); PG8_SCHED; PG8_LDA(At, 0, 0); PG8_STAGE(PG8_SA(1, 1), a1 + hstep, voffA);
            PG8_WAIT_L(8); PG8_BAR; PG8_WAIT_L(0); PG8_MMA(0, 0, At, B0); PG8_BAR; PG8_SCHED;
            PG8_LDB(B1, 0, 1); PG8_STAGE(PG8_SB(0, 0), b2, vB2);
            PG8_BAR; PG8_WAIT_L(0); PG8_MMA(0, 1, At, B1); PG8_BAR;
            PG8_LDA(At, 0, 1); PG8_STAGE(PG8_SA(0, 0), a2, vA2);
            PG8_BAR; PG8_WAIT_L(0); PG8_MMA(1, 0, At, B0); PG8_BAR; PG8_SCHED;
            PG8_STAGE(PG8_SB(0, 1), b2 + h2, vB2);
            PG8_WAIT_V(6); PG8_BAR; PG8_MMA(1, 1, At, B1); PG8_BAR;
            PG8_LDB(B0, 1, 0); PG8_SCHED; PG8_LDA(At, 1, 0); PG8_STAGE(PG8_SA(0, 1), a2 + h2, vA2);
            PG8_WAIT_L(8); PG8_BAR; PG8_WAIT_L(0); PG8_MMA(0, 0, At, B0); PG8_BAR; PG8_SCHED;
            PG8_LDB(B1, 1, 1); PG8_STAGE(PG8_SB(1, 0), b3, vB2);
            PG8_BAR; PG8_WAIT_L(0); PG8_MMA(0, 1, At, B1); PG8_BAR;
            PG8_LDA(At, 1, 1); PG8_STAGE(PG8_SA(1, 0), a3, vA2);
            PG8_BAR; PG8_WAIT_L(0); PG8_MMA(1, 0, At, B0); PG8_BAR; PG8_SCHED;
            PG8_STAGE(PG8_SB(1, 1), b3 + h2, vB2);
            PG8_WAIT_V(6); PG8_BAR; PG8_MMA(1, 1, At, B1); PG8_BAR;
        }
        PG8_STAMP();
        {
            const int row0 = cur.pm * BM + wr * 64 + fr, col0 = cur.pn * BM + wc * 32 + 8 * fq;
#pragma unroll
            for (int ai = 0; ai < 2; ++ai)
#pragma unroll
                for (int m = 0; m < 4; ++m) { const size_t row = (size_t)(row0 + ai * HALF + m * 16);
                    const float rs = (sub == 0) ? rsqrtf(g.SSY[row] * (1.f / 2048.f) + 1e-6f) : 1.f;
#pragma unroll
                    for (int bj = 0; bj < 2; ++bj) { const bf16_t* gp = g.GL + row * g.ldg + col0 + bj * HALF;
                        f32x4 v0 = acc[ai][bj][m][0] * rs, v1 = acc[ai][bj][m][1] * rs;
                        if (sub < 2) { const u32x4 ga = *(const u32x4*)(gp + sub * 2048), gb = *(const u32x4*)(gp + (sub + 1) * 2048);
#define PG8_RAT(x, y) ((1.0f + __expf(-(y))) * __builtin_amdgcn_rcpf(1.0f + __expf(-(x))))
                            v0[0] *= PG8_RAT(bflo(ga.x), bflo(gb.x)); v0[1] *= PG8_RAT(bfhi(ga.x), bfhi(gb.x)); v0[2] *= PG8_RAT(bflo(ga.y), bflo(gb.y)); v0[3] *= PG8_RAT(bfhi(ga.y), bfhi(gb.y));
                            v1[0] *= PG8_RAT(bflo(ga.z), bflo(gb.z)); v1[1] *= PG8_RAT(bfhi(ga.z), bfhi(gb.z)); v1[2] *= PG8_RAT(bflo(ga.w), bflo(gb.w)); v1[3] *= PG8_RAT(bfhi(ga.w), bfhi(gb.w));
#undef PG8_RAT
                            acc[ai][bj][m][0] = v0; acc[ai][bj][m][1] = v1;
                        } else { const u32x4 gc = *(const u32x4*)(gp + 4096);
                            u32x4 w; w.x = cvt_pk_bf16(v0[0] * sigmoidf_(bflo(gc.x)), v0[1] * sigmoidf_(bfhi(gc.x))); w.y = cvt_pk_bf16(v0[2] * sigmoidf_(bflo(gc.y)), v0[3] * sigmoidf_(bfhi(gc.y)));
                            w.z = cvt_pk_bf16(v1[0] * sigmoidf_(bflo(gc.z)), v1[1] * sigmoidf_(bfhi(gc.z))); w.w = cvt_pk_bf16(v1[2] * sigmoidf_(bflo(gc.w)), v1[3] * sigmoidf_(bfhi(gc.w)));
                            *(u32x4*)(g.MB + row * 2048 + col0 + bj * HALF) = w;
                            acc[ai][bj][m][0] = (f32x4){0.f, 0.f, 0.f, 0.f}; acc[ai][bj][m][1] = (f32x4){0.f, 0.f, 0.f, 0.f}; } } }
        }
        PG8_STAMP();
        if (!has_next) break;
        if (sub == 2) ++ui;
        cur = nxt; cA = nA; cB = nB; sub = subn; Kc = Kn; nt = Kc / BK; hstep = hstepn;
#pragma unroll
        for (int i = 0; i < 2; ++i) { voffA[i] = voffAn[i]; voffB[i] = voffBn[i]; }
    }
    PG8_WAIT_V(0);
    if (wr == 0) PG8_BAR;
    PG8_BAR;
    PG8_STAMP();
    if (STAMP && wid == 0) { stamps[lane] = lane < nts ? (((unsigned long long)(unsigned)ts_hi << 32) | (unsigned)ts_lo) : 0ull;
        if (lane == 62) stamps[62] = rt_entry; if (lane == 63) stamps[63] = (unsigned long long)wall_clock64(); }
#undef PG8_STAMP
#undef PG8_SA
#undef PG8_SB
#undef PG8_STAGE
#undef PG8_LDA
#undef PG8_LDB
#undef PG8_MMA
#undef PG8_WAIT_V
#undef PG8_WAIT_L
#undef PG8_BAR
#undef PG8_SCHED
}
}

using pg8::bf16_t; using pg8::f32x4; using pg8::u32x4; using pg8::f32x2; using pg8::u32x2;
using pg8::bf2f; using pg8::bflo; using pg8::bfhi; using pg8::sigmoidf_; using pg8::siluf_; using pg8::cvt_pk_bf16;
#define LAS __attribute__((address_space(3)))
constexpr int SEQ = 2048, MTOK = 8192, DM = 2048, NIN = 20512, NP = 20736, PLE = 256, CONVC = 3072;
constexpr int C_ZSSD = 0, C_XBC = 2048, C_UPOOL = 5120, C_ZPOOL = 7168, C_Q = 9216, C_K = 10752, C_V = 12288, C_ZATTN = 13824, C_GATES = 14336, C_DT = 20480;
constexpr float RMS_EPS = 1e-6f;
constexpr size_t MiB = 1u << 20;
constexpr size_t WS_WT_IN = 0, WT_IN_STRIDE = (size_t)NP * DM;
constexpr size_t WS_WT_BRSSD = 162 * MiB, WS_WT_BRPOOL = 178 * MiB, WS_WT_OUT = 194 * MiB, WS_WT_GATE = 210 * MiB;
constexpr size_t WS_WT_BRATTN = 226 * MiB, WS_WT_POOL = 230 * MiB, WS_WT_PROJ = 234 * MiB, WS_PBF = 236 * MiB;
constexpr size_t WS_H = 244 * MiB, WS_PROJ = 276 * MiB, WS_XBC = 600 * MiB, WS_DT = 648 * MiB, WS_DA = 649 * MiB;
constexpr size_t WS_YRAW = 650 * MiB, WS_YSSD = 682 * MiB, WS_POOLED = 714 * MiB, WS_YPOOL = 746 * MiB;
constexpr size_t WS_QN = 778 * MiB, WS_KN = 802 * MiB, WS_VT = 826 * MiB, WS_YATTN = 850 * MiB;
constexpr size_t WS_MF = 858 * MiB, WS_MB = 922 * MiB, WS_H2 = 954 * MiB, WS_PP = 986 * MiB, WS_XT = 1050 * MiB, WS_BT = 1082 * MiB, WS_OG = 1090 * MiB, WS_LSE = 1114 * MiB, WS_SS = 1115 * MiB, WS_BAR = 1116 * MiB, WS_END = 1117 * MiB;
constexpr int LDS_BYTES = 148480;

#ifndef EXP
#define EXP 0
#endif
#define REP(k) for (int rep_ = 0; rep_ < ((EXP == (k)) ? 2 : 1); ++rep_)
struct Params { const float* in[21]; float* out; unsigned char* ws; };
enum { I_X = 0, I_P, I_NORM_G, I_W_IN, I_CONV_W, I_CONV_B, I_DT_BIAS, I_A_LOG, I_D_SKIP, I_SSD_NORM_G, I_W_BR_SSD, I_POOL_W, I_POOL_SCALE, I_W_BR_POOL,
       I_Q_NORM_G, I_K_NORM_G, I_W_BR_ATTN, I_W_OUT, I_PLE_NORM_G, I_W_PLE_GATE, I_W_PLE_PROJ };

__device__ __forceinline__ float wave_sum(float v) {
#pragma unroll
    for (int o = 1; o < 64; o <<= 1) v += __shfl_xor(v, o);
    return v;
}
#define LDS_WAIT() asm volatile("s_waitcnt lgkmcnt(0)" ::: "memory")

#define XB_TMO      128
#define XB_XCNT(j)  (256  + 64 * (j))
#define XB_XSUB(j)  (1280 + 64 * (j))
#define XB_XGEN(j)  (2304 + 64 * (j))
#define XB_TOP      3328
#define XB_TOPGEN   3392
#define XCD_BAR_WORDS 3456
#define XB_SPIN_CAP (1u << 18)

__device__ __forceinline__ unsigned xb_ld(unsigned* p)              { return __hip_atomic_load(p, __ATOMIC_RELAXED, __HIP_MEMORY_SCOPE_AGENT); }
__device__ __forceinline__ unsigned xb_add(unsigned* p, unsigned v) { return __hip_atomic_fetch_add(p, v, __ATOMIC_RELAXED, __HIP_MEMORY_SCOPE_AGENT); }
__device__ __forceinline__ unsigned xb_xcc_id() { return (unsigned)__builtin_amdgcn_s_getreg((3 << 11) | 20) & 0xFu; }
#define XB_SPIN(cond, bar) do { unsigned _sp = 0; while (cond) { __builtin_amdgcn_s_sleep(1); \
    if ((++_sp & 255u) == 0u) { if (xb_ld(&(bar)[XB_TMO])) break; if (_sp > XB_SPIN_CAP) { atomicAdd(&(bar)[XB_TMO], 1u); break; } } } } while (0)

struct XcdBarrier {
    unsigned* bar; unsigned x;
    volatile LAS unsigned* st;
};

__device__ __forceinline__ XcdBarrier xcd_barrier_post(unsigned* bar, volatile LAS unsigned* st) {
    XcdBarrier b; b.bar = bar; b.x = xb_xcc_id(); b.st = st;
    if (threadIdx.x == 0) (void)xb_add(&bar[XB_XCNT(b.x)], 1u);
    return b;
}
__device__ __forceinline__ void xcd_barrier_complete(unsigned* bar, unsigned x, unsigned& nloc, unsigned& nx) {
    const unsigned G = gridDim.x * gridDim.y * gridDim.z;
    unsigned sum, cnt, mine, sp = 0u;
    for (;;) {
        sum = 0u; cnt = 0u; mine = 0u;
#pragma unroll
        for (unsigned j = 0; j < 16; ++j) { const unsigned c = xb_ld(&bar[XB_XCNT(j)]); sum += c; cnt += (c > 0u) ? 1u : 0u; mine = (j == x) ? c : mine; }
        if (sum == G) break;
        __builtin_amdgcn_s_sleep(1);
        if ((++sp & 255u) == 0u) { if (xb_ld(&bar[XB_TMO])) break; if (sp > XB_SPIN_CAP) { atomicAdd(&bar[XB_TMO], 1u); break; } }
    }
    nloc = mine > 0u ? mine : 1u; nx = cnt > 0u ? cnt : 1u;
}

__device__ __forceinline__ void xcd_barrier(const XcdBarrier& b) {
    asm volatile("s_waitcnt vmcnt(0)" ::: "memory");
    __syncthreads();
    if (threadIdx.x == 0) {
        unsigned* bar = b.bar;
        __builtin_amdgcn_s_waitcnt(0);
        unsigned nloc = b.st[0], nx = b.st[1];
        if (nloc == 0u) { xcd_barrier_complete(bar, b.x, nloc, nx); b.st[0] = nloc; b.st[1] = nx; }
        const unsigned old = xb_add(&bar[XB_XSUB(b.x)], 1u);
        const unsigned gen = old / nloc;
        if (old + 1u == (gen + 1u) * nloc) {
            __builtin_amdgcn_fence(__ATOMIC_RELEASE, "agent");
            asm volatile("s_waitcnt vmcnt(0)" ::: "memory");
            const unsigned og = xb_add(&bar[XB_TOP], 1u);
            const unsigned tg = og / nx;
            if (og + 1u == (tg + 1u) * nx) xb_add(&bar[XB_TOPGEN], 1u);
            else XB_SPIN(xb_ld(&bar[XB_TOPGEN]) == tg, bar);
            __builtin_amdgcn_fence(__ATOMIC_ACQUIRE, "agent");
            xb_add(&bar[XB_XGEN(b.x)], 1u);
            asm volatile("s_waitcnt vmcnt(0)" ::: "memory");
        } else {
            XB_SPIN(xb_ld(&bar[XB_XGEN(b.x)]) == gen, bar);
            __builtin_amdgcn_fence(__ATOMIC_ACQUIRE, "agent");
            asm volatile("s_waitcnt vmcnt(0)" ::: "memory");
        }
    }
    __syncthreads();
}


__device__ __forceinline__ void transpose_item(const float* W, int K, int N, bf16_t* WT, int remap, LAS float* scr, int item, int lane, const float* gk = nullptr) {
    LAS bf16_t* T = (LAS bf16_t*)scr;
    const int nblk = N / 32, kb = item / nblk, nb = item % nblk, k0 = 128 * kb, n0 = 32 * nb;
    const int ksub = lane >> 3, n4 = (lane & 7) * 4;
    f32x4 v[16];
#pragma unroll
    for (int i = 0; i < 16; ++i) v[i] = *(const f32x4*)(W + (size_t)(k0 + i * 8 + ksub) * N + n0 + n4);
    if (gk) {
#pragma unroll
        for (int i = 0; i < 16; ++i) v[i] *= gk[k0 + i * 8 + ksub]; }
#pragma unroll
    for (int i = 0; i < 16; ++i) { const int k = i * 8 + ksub; const unsigned p01 = cvt_pk_bf16(v[i][0], v[i][1]), p23 = cvt_pk_bf16(v[i][2], v[i][3]);
        T[(n4 + 0) * 136 + k] = (bf16_t)(p01 & 0xffffu); T[(n4 + 1) * 136 + k] = (bf16_t)(p01 >> 16); T[(n4 + 2) * 136 + k] = (bf16_t)(p23 & 0xffffu); T[(n4 + 3) * 136 + k] = (bf16_t)(p23 >> 16); }
    LDS_WAIT(); asm volatile("" ::: "memory");
    int d0 = n0;
    if (remap) d0 = (n0 < 5120) ? n0 : ((n0 < 5152) ? (C_DT + (n0 - 5120)) : (n0 - 32));
    const int nsub = lane >> 4, kc = (lane & 15) * 8;
#pragma unroll
    for (int j = 0; j < 8; ++j) { const int n = j * 4 + nsub;
        *(u32x4*)(WT + (size_t)(d0 + n) * K + k0 + kc) = *(const LAS u32x4*)(T + n * 136 + kc); }
    LDS_WAIT(); asm volatile("" ::: "memory");
}

__device__ __forceinline__ void row_to_bf16_ss(const float* xrow, bf16_t* orow, float* ssp, int lane) {
    float s = 0.f;
#pragma unroll
    for (int j = 0; j < 8; ++j) { const f32x4 v = *(const f32x4*)(xrow + 256 * j + 4 * lane); s += (v[0] * v[0] + v[1] * v[1]) + (v[2] * v[2] + v[3] * v[3]);
        u32x2 w; w.x = cvt_pk_bf16(v[0], v[1]); w.y = cvt_pk_bf16(v[2], v[3]); *(u32x2*)(orow + 256 * j + 4 * lane) = w; }
    s = wave_sum(s);
    if (lane == 0) *ssp = s;
}
__device__ __forceinline__ void rms_row_to_bf16(const float* xrow, const float* g, bf16_t* orow, int lane) {
    f32x4 v[8]; float s = 0.f;
#pragma unroll
    for (int j = 0; j < 8; ++j) { v[j] = *(const f32x4*)(xrow + 256 * j + 4 * lane); s += (v[j][0] * v[j][0] + v[j][1] * v[j][1]) + (v[j][2] * v[j][2] + v[j][3] * v[j][3]); }
    const float rinv = rsqrtf(wave_sum(s) * (1.f / 2048.f) + RMS_EPS);
#pragma unroll
    for (int j = 0; j < 8; ++j) { const f32x4 gg = *(const f32x4*)(g + 256 * j + 4 * lane);
        u32x2 w; w.x = cvt_pk_bf16(v[j][0] * rinv * gg[0], v[j][1] * rinv * gg[1]); w.y = cvt_pk_bf16(v[j][2] * rinv * gg[2], v[j][3] * rinv * gg[3]);
        *(u32x2*)(orow + 256 * j + 4 * lane) = w; }
}


typedef short bf16x8 __attribute__((ext_vector_type(8)));
typedef short bf16x4 __attribute__((ext_vector_type(4)));
typedef float f32x16 __attribute__((ext_vector_type(16)));
typedef __bf16 bf16v2 __attribute__((ext_vector_type(2)));
#define MFMA32(a, b, c) __builtin_amdgcn_mfma_f32_32x32x16_bf16((a), (b), (c), 0, 0, 0)
__device__ __forceinline__ unsigned pkbf(float lo, float hi) { f32x2 v = {lo, hi}; return __builtin_bit_cast(unsigned, __builtin_convertvector(v, bf16v2)); }
__device__ __forceinline__ bf16x8 pack8(float a, float b, float c, float d, float e, float f, float g, float h) {
    u32x4 w = {pkbf(a, b), pkbf(c, d), pkbf(e, f), pkbf(g, h)}; return __builtin_bit_cast(bf16x8, w); }

__device__ __forceinline__ void wave_tile_transpose_store(const LAS bf16_t* tile, bf16_t* dst, int lane) {
#pragma unroll
    for (int half = 0; half < 2; ++half) { const int cc = lane + 64 * half;
        unsigned w[16];
#pragma unroll
        for (int i = 0; i < 16; ++i) w[i] = (unsigned)tile[(2 * i) * 136 + cc] | ((unsigned)tile[(2 * i + 1) * 136 + cc] << 16);
        bf16_t* d = dst + (size_t)cc * SEQ;
#pragma unroll
        for (int q = 0; q < 4; ++q) *(u32x4*)(d + 8 * q) = (u32x4){w[4 * q], w[4 * q + 1], w[4 * q + 2], w[4 * q + 3]}; }
}

template <int KS> __device__ __forceinline__ void wave_tile_transpose_store_frag(const LAS bf16_t* tile, bf16_t* dst, int rt0, int half32, int lane) {
#pragma unroll
    for (int half = 0; half < 2; ++half) { const int cc = lane + 64 * half;
        unsigned w[16];
#pragma unroll
        for (int i = 0; i < 16; ++i) w[i] = (unsigned)tile[(2 * i) * 136 + cc] | ((unsigned)tile[(2 * i + 1) * 136 + cc] << 16);
        const int rt = rt0 + (cc >> 5);
#pragma unroll
        for (int q = 0; q < 4; ++q) { const int ks = half32 * 2 + (q >> 1), hh = q & 1;
            *(u32x4*)(dst + ((size_t)(rt * KS + ks)) * 512 + (hh * 32 + (cc & 31)) * 8) = (u32x4){w[4 * q], w[4 * q + 1], w[4 * q + 2], w[4 * q + 3]}; } }
}

__device__ __forceinline__ void attn_item(const bf16_t* QNp, const bf16_t* KNp, const bf16_t* VTp, bf16_t* OGp, float* LSEp, int item, int lane) {
    const int g = item >> 10; int rem = item & 1023;
    const int b = rem >> 8; rem &= 255; const int j = rem >> 6; rem &= 63;
    const int sh = 2 * g, dil = 1 << sh, ld = SEQ >> sh;
    const int pos0 = rem * 32, r = pos0 >> (11 - sh), s0 = pos0 & (ld - 1), head = g * 4 + j;
    const int qc = lane & 31, hh = lane >> 5;
    const size_t mq = (size_t)b * SEQ + (size_t)(s0 + qc) * dil + r;
    bf16x8 qf[8];
#pragma unroll
    for (int ks = 0; ks < 8; ++ks) qf[ks] = *(const bf16x8*)(QNp + ((size_t)(((b * 12 + head) * 64 + rem) * 8 + ks)) * 512 + lane * 8);
    f32x16 o[4];
#pragma unroll
    for (int d = 0; d < 4; ++d)
#pragma unroll
        for (int i = 0; i < 16; ++i) o[d][i] = 0.f;
    float mrun = -INFINITY, lh = 0.f;
    const bf16_t* kfb = KNp + ((size_t)((b * 12 + head) * 64 + rem - 4) * 8) * 512 + lane * 8;
    const bf16_t* vtb = VTp + ((size_t)((b * 12 + head) * 64 + rem - 4) * 8) * 512 + qc * 8 + 4 * hh;
    const float sc = 0.08838834764831845f * 1.4426950408889634f;
    const int kt0 = (s0 >= 128) ? 0 : (4 - (s0 >> 5));
    bf16x8 kf[8];
#pragma unroll
    for (int ks = 0; ks < 8; ++ks) kf[ks] = *(const bf16x8*)(kfb + kt0 * 4096 + ks * 512);
#pragma unroll 1
    for (int kt = kt0; kt < 5; ++kt) {
        bf16x4 vlo[8], vhi[8];
#pragma unroll
        for (int q = 0; q < 8; ++q) { const bf16_t* vp = vtb + kt * 4096 + q * 512; vlo[q] = *(const bf16x4*)vp; vhi[q] = *(const bf16x4*)(vp + 256); }
        const int ktn = (kt < 4) ? kt + 1 : kt;
        bf16x8 kn[8];
#pragma unroll
        for (int ks = 0; ks < 8; ++ks) kn[ks] = *(const bf16x8*)(kfb + ktn * 4096 + ks * 512);
        f32x16 sa, sb;
#pragma unroll
        for (int i = 0; i < 16; ++i) { sa[i] = 0.f; sb[i] = 0.f; }
#pragma unroll
        for (int ks = 0; ks < 8; ks += 2) { sa = MFMA32(kf[ks], qf[ks], sa); sb = MFMA32(kf[ks + 1], qf[ks + 1], sb); }
        float tmax = -INFINITY;
#pragma unroll
        for (int i = 0; i < 16; ++i) { const int kr = (i & 3) + 8 * (i >> 2) + 4 * hh;
            const bool ok = (kt == 0) ? (kr >= qc) : ((kt == 4) ? (kr <= qc) : true);
            const float v = ok ? (sa[i] + sb[i]) * sc : -INFINITY; sa[i] = v; tmax = fmaxf(tmax, v); }
        tmax = fmaxf(tmax, __shfl_xor(tmax, 32));
        const float mnew = fmaxf(mrun, tmax), alpha = __builtin_amdgcn_exp2f(mrun - mnew); mrun = mnew;
        float psum = 0.f;
#pragma unroll
        for (int i = 0; i < 16; ++i) { const float p = __builtin_amdgcn_exp2f(sa[i] - mnew); sa[i] = p; psum += p; }
        lh = lh * alpha + psum;
#pragma unroll
        for (int d = 0; d < 4; ++d)
#pragma unroll
            for (int i = 0; i < 16; ++i) o[d][i] *= alpha;
#pragma unroll
        for (int ks2 = 0; ks2 < 2; ++ks2) {
            const bf16x8 pf = pack8(sa[8 * ks2 + 0], sa[8 * ks2 + 1], sa[8 * ks2 + 2], sa[8 * ks2 + 3], sa[8 * ks2 + 4], sa[8 * ks2 + 5], sa[8 * ks2 + 6], sa[8 * ks2 + 7]);
#pragma unroll
            for (int d = 0; d < 4; ++d) {
                const bf16x8 vf = __builtin_shufflevector(vlo[d * 2 + ks2], vhi[d * 2 + ks2], 0, 1, 2, 3, 4, 5, 6, 7);
                o[d] = MFMA32(vf, pf, o[d]); }
        }
#pragma unroll
        for (int ks = 0; ks < 8; ++ks) kf[ks] = kn[ks];
    }
    const float l = lh + __shfl_xor(lh, 32), il = 1.f / l;
    bf16_t* op = OGp + ((size_t)g * MTOK + mq) * 512 + j * 128;
#pragma unroll
    for (int d = 0; d < 4; ++d)
#pragma unroll
        for (int i4 = 0; i4 < 4; ++i4) { u32x2 w; w.x = pkbf(o[d][4 * i4] * il, o[d][4 * i4 + 1] * il); w.y = pkbf(o[d][4 * i4 + 2] * il, o[d][4 * i4 + 3] * il);
            *(u32x2*)(op + d * 32 + 8 * i4 + 4 * hh) = w; }
    if (hh == 0) LSEp[((size_t)g * MTOK + mq) * 4 + j] = mrun * 0.6931471805599453f + __logf(l);
}

__device__ __forceinline__ void ssd_block(LAS unsigned char* lds, const bf16_t* CFp, const bf16_t* BFp, const bf16_t* XTp, const bf16_t* BTp, const float* DTp, const float* DAp, bf16_t* YRAWp, const bf16_t* Zp, float* SSYp, float Dh, int b, int h, int tid) {
    const int lane = tid & 63, wave = __builtin_amdgcn_readfirstlane(tid >> 6), qc = lane & 31, hh = lane >> 5, g = h >> 3;
    LAS bf16_t* Sb0 = (LAS bf16_t*)lds; LAS bf16_t* Sb1 = (LAS bf16_t*)(lds + 17408);
    LAS float* cumL = (LAS float*)(lds + 36864 + wave * 1024); LAS float* dtL = cumL + 64; LAS float* wL = cumL + 128;
    for (int i = tid; i < 17408 / 4; i += 512) ((LAS unsigned*)Sb0)[i] = 0u;
    const int pt = wave & 1, lt = (wave >> 1) & 1, l = lt * 32 + qc, nt0 = 2 * lt;
    const bool ywave = wave < 4;
    const bf16_t* cfb = CFp + ((size_t)(b * 32) * 4 + g) * 8192 + lt * 4096 + lane * 8;
    const bf16_t* bfb = BFp + ((size_t)(b * 32) * 4 + g) * 8192 + lane * 8;
    const bf16_t* xtb = XTp + ((size_t)(b * 32) * 64 + h * 2 + pt) * 2048;
    const bf16_t* btb = BTp + ((size_t)(b * 32) * 16 + g * 4 + nt0) * 2048 + lane * 8;
    LAS unsigned char* FB = lds + 49152;
    const bf16_t* cfc = CFp + ((size_t)(b * 32) * 4 + g) * 8192 + lane * 8;
    const bf16_t* bfc = BFp + ((size_t)(b * 32) * 4 + g) * 8192 + lane * 8;
    const bf16_t* btc = BTp + ((size_t)(b * 32) * 4 + g) * 8192 + lane * 8;
#define SSD_DMA(cc, bi) do { _Pragma("unroll") for (int q_ = 0; q_ < 6; ++q_) { const int j_ = wave * 6 + q_; \
        const bf16_t* src_ = ((j_ < 16) ? cfc : ((j_ < 32) ? bfc : btc)) + (size_t)(cc) * 32768 + (j_ & 15) * 512; \
        __builtin_amdgcn_global_load_lds((const unsigned*)src_, (LAS unsigned*)(FB + (bi) * 49152 + j_ * 1024), 16, 0, 0); } } while (0)
    SSD_DMA(0, 0); SSD_DMA(1, 1);
    asm volatile("s_waitcnt vmcnt(0)" ::: "memory");
    __syncthreads();
    if (ywave) {
        bf16x8 cf[8], bf0[8], bf1[8]; bf16x4 xk[4][2];
        float dav = DAp[((size_t)b * SEQ + lane) * 32 + h], dtv = DTp[((size_t)b * SEQ + lane) * 32 + h];
#pragma unroll
        for (int q = 0; q < 4; ++q) { xk[q][0] = *(const bf16x4*)(xtb + q * 512 + qc * 8 + 4 * hh); xk[q][1] = *(const bf16x4*)(xtb + q * 512 + (32 + qc) * 8 + 4 * hh); }
#pragma unroll 1
        for (int c = 0; c < 32; ++c) {
            const int t0 = c * 64, cn = (c < 31) ? c + 1 : c; const size_t m0 = (size_t)b * SEQ + t0;
            LAS bf16_t* Scur = (c & 1) ? Sb1 : Sb0;
            { const LAS unsigned char* fb = FB + (c & 1) * 49152 + lane * 16;
#pragma unroll
              for (int ks = 0; ks < 8; ++ks) { cf[ks] = *(const LAS bf16x8*)(fb + (lt * 8 + ks) * 1024); bf0[ks] = *(const LAS bf16x8*)(fb + 16384 + ks * 1024); bf1[ks] = *(const LAS bf16x8*)(fb + 24576 + ks * 1024); } }
            u32x2 zz[4];
#pragma unroll
            for (int i4 = 0; i4 < 4; ++i4) zz[i4] = *(const u32x2*)(Zp + (m0 + l) * NP + h * 64 + pt * 32 + 8 * i4 + 4 * hh);
            cumL[lane] = dav; dtL[lane] = dtv;
            LDS_WAIT(); asm volatile("" ::: "memory");
            f32x16 y, cb0, cb1;
#pragma unroll
            for (int i = 0; i < 16; ++i) { y[i] = 0.f; cb0[i] = 0.f; cb1[i] = 0.f; }
            if (lt == 1) {
#pragma unroll
                for (int ks = 0; ks < 8; ++ks) { const bf16x8 sf = *(const LAS bf16x8*)(Scur + (pt * 32 + qc) * 136 + ks * 16 + hh * 8);
                    y = MFMA32(sf, cf[ks], y); cb0 = MFMA32(bf0[ks], cf[ks], cb0); cb1 = MFMA32(bf1[ks], cf[ks], cb1); }
            } else {
#pragma unroll
                for (int ks = 0; ks < 8; ++ks) { const bf16x8 sf = *(const LAS bf16x8*)(Scur + (pt * 32 + qc) * 136 + ks * 16 + hh * 8);
                    y = MFMA32(sf, cf[ks], y); cb0 = MFMA32(bf0[ks], cf[ks], cb0); }
            }
            dav = DAp[((size_t)b * SEQ + cn * 64 + lane) * 32 + h]; dtv = DTp[((size_t)b * SEQ + cn * 64 + lane) * 32 + h];
            const float cuml = cumL[l], el = __builtin_amdgcn_exp2f(cuml);
#pragma unroll
            for (int i = 0; i < 16; ++i) y[i] *= el;
#pragma unroll
            for (int st = 0; st < 2; ++st) if (st <= lt) {
                f32x16 cb = (st == 0) ? cb0 : cb1;
#pragma unroll
                for (int i4 = 0; i4 < 4; ++i4) { const int sb = st * 32 + 8 * i4 + 4 * hh;
                    const f32x4 cs = *(const LAS f32x4*)(cumL + sb), ds = *(const LAS f32x4*)(dtL + sb);
#pragma unroll
                    for (int e = 0; e < 4; ++e) { const float v = cb[4 * i4 + e] * __builtin_amdgcn_exp2f(cuml - cs[e]) * ds[e]; cb[4 * i4 + e] = (st < lt) ? v : ((sb + e < l) ? v : ((sb + e == l) ? v + Dh : 0.f)); } }
#pragma unroll
                for (int ks2 = 0; ks2 < 2; ++ks2) {
                    const bf16x8 pf = pack8(cb[8 * ks2 + 0], cb[8 * ks2 + 1], cb[8 * ks2 + 2], cb[8 * ks2 + 3], cb[8 * ks2 + 4], cb[8 * ks2 + 5], cb[8 * ks2 + 6], cb[8 * ks2 + 7]);
                    const bf16x8 xa = __builtin_shufflevector(xk[2 * st + ks2][0], xk[2 * st + ks2][1], 0, 1, 2, 3, 4, 5, 6, 7);
                    y = MFMA32(xa, pf, y); }
            }
#pragma unroll
            for (int q = 0; q < 4; ++q) { xk[q][0] = *(const bf16x4*)(xtb + (size_t)cn * 131072 + q * 512 + qc * 8 + 4 * hh); xk[q][1] = *(const bf16x4*)(xtb + (size_t)cn * 131072 + q * 512 + (32 + qc) * 8 + 4 * hh); }
            float ssy = 0.f;
#pragma unroll
            for (int i4 = 0; i4 < 4; ++i4) { const int p0 = pt * 32 + 8 * i4 + 4 * hh;
                u32x2 w; w.x = pkbf(y[4 * i4] * siluf_(bflo(zz[i4].x)), y[4 * i4 + 1] * siluf_(bfhi(zz[i4].x))); w.y = pkbf(y[4 * i4 + 2] * siluf_(bflo(zz[i4].y)), y[4 * i4 + 3] * siluf_(bfhi(zz[i4].y)));
                *(u32x2*)(YRAWp + (m0 + l) * DM + h * 64 + p0) = w;
                const float r0 = bflo(w.x), r1 = bfhi(w.x), r2 = bflo(w.y), r3 = bfhi(w.y); ssy += (r0 * r0 + r1 * r1) + (r2 * r2 + r3 * r3); }
            ssy += __shfl_xor(ssy, 32);
            if (hh == 0) unsafeAtomicAdd(SSYp + m0 + l, ssy);
            asm volatile("s_waitcnt vmcnt(0)" ::: "memory");
            __syncthreads();
            if (c + 2 < 32) SSD_DMA(c + 2, c & 1);
        }
    } else {
        f32x16 sacc0, sacc1;
#pragma unroll
        for (int i = 0; i < 16; ++i) { sacc0[i] = 0.f; sacc1[i] = 0.f; }
        bf16x8 af0[4], af1[4]; u32x4 xr[4];
        float dav = DAp[((size_t)b * SEQ + lane) * 32 + h], dtv = DTp[((size_t)b * SEQ + lane) * 32 + h];
#pragma unroll
        for (int ks = 0; ks < 4; ++ks) xr[ks] = *(const u32x4*)(xtb + ks * 512 + lane * 8);
#pragma unroll 1
        for (int c = 0; c < 32; ++c) {
            const int cn = (c < 31) ? c + 1 : c;
            LAS bf16_t* Snxt = (c & 1) ? Sb0 : Sb1;
            { const LAS unsigned char* fb = FB + (c & 1) * 49152 + 32768 + lane * 16;
#pragma unroll
              for (int ks = 0; ks < 4; ++ks) { af0[ks] = *(const LAS bf16x8*)(fb + (nt0 * 4 + ks) * 1024); af1[ks] = *(const LAS bf16x8*)(fb + (nt0 * 4 + 4 + ks) * 1024); } }
            const float cum = dav, cl = __shfl(cum, 63);
            wL[lane] = dtv * __builtin_amdgcn_exp2f(cl - cum);
            LDS_WAIT(); asm volatile("" ::: "memory");
            const float ecl = __builtin_amdgcn_exp2f(cl);
#pragma unroll
            for (int i = 0; i < 16; ++i) { sacc0[i] *= ecl; sacc1[i] *= ecl; }
#pragma unroll
            for (int ks = 0; ks < 4; ++ks) {
                const f32x4 w0 = *(const LAS f32x4*)(wL + ks * 16 + hh * 8), w1 = *(const LAS f32x4*)(wL + ks * 16 + hh * 8 + 4);
                const bf16x8 xw = pack8(bflo(xr[ks].x) * w0[0], bfhi(xr[ks].x) * w0[1], bflo(xr[ks].y) * w0[2], bfhi(xr[ks].y) * w0[3], bflo(xr[ks].z) * w1[0], bfhi(xr[ks].z) * w1[1], bflo(xr[ks].w) * w1[2], bfhi(xr[ks].w) * w1[3]);
                sacc0 = MFMA32(af0[ks], xw, sacc0); sacc1 = MFMA32(af1[ks], xw, sacc1); }
            dav = DAp[((size_t)b * SEQ + cn * 64 + lane) * 32 + h]; dtv = DTp[((size_t)b * SEQ + cn * 64 + lane) * 32 + h];
#pragma unroll
            for (int ks = 0; ks < 4; ++ks) xr[ks] = *(const u32x4*)(xtb + (size_t)cn * 131072 + ks * 512 + lane * 8);
#pragma unroll
            for (int i4 = 0; i4 < 4; ++i4) { u32x2 w; w.x = pkbf(sacc0[4 * i4], sacc0[4 * i4 + 1]); w.y = pkbf(sacc0[4 * i4 + 2], sacc0[4 * i4 + 3]);
                *(LAS u32x2*)(Snxt + (pt * 32 + qc) * 136 + nt0 * 32 + 8 * i4 + 4 * hh) = w;
                u32x2 v; v.x = pkbf(sacc1[4 * i4], sacc1[4 * i4 + 1]); v.y = pkbf(sacc1[4 * i4 + 2], sacc1[4 * i4 + 3]);
                *(LAS u32x2*)(Snxt + (pt * 32 + qc) * 136 + nt0 * 32 + 32 + 8 * i4 + 4 * hh) = v; }
            asm volatile("s_waitcnt vmcnt(0)" ::: "memory");
            __syncthreads();
            if (c + 2 < 32) SSD_DMA(c + 2, c & 1);
        }
    }
}
#undef SSD_DMA

#define WT_IN ((bf16_t*)(ws + WS_WT_IN))
#define WT_BRSSD ((bf16_t*)(ws + WS_WT_BRSSD))
#define WT_BRPOOL ((bf16_t*)(ws + WS_WT_BRPOOL))
#define WT_OUT ((bf16_t*)(ws + WS_WT_OUT))
#define WT_GATE ((bf16_t*)(ws + WS_WT_GATE))
#define WT_BRATTN ((bf16_t*)(ws + WS_WT_BRATTN))
#define WT_POOL ((bf16_t*)(ws + WS_WT_POOL))
#define WT_PROJ ((bf16_t*)(ws + WS_WT_PROJ))
#define PBF ((bf16_t*)(ws + WS_PBF))
#define H ((bf16_t*)(ws + WS_H))
#define PROJ ((bf16_t*)(ws + WS_PROJ))
#define CF ((bf16_t*)(ws + WS_XBC))
#define BF ((bf16_t*)(ws + WS_XBC + 8 * MiB))
#define DTP ((float*)(ws + WS_XBC + 16 * MiB))
#define DT ((float*)(ws + WS_DT))
#define DA ((float*)(ws + WS_DA))
#define YRAW ((bf16_t*)(ws + WS_YRAW))
#define YSSD ((bf16_t*)(ws + WS_YSSD))
#define POOLED ((bf16_t*)(ws + WS_POOLED))
#define YPOOL ((bf16_t*)(ws + WS_YPOOL))
#define QN ((bf16_t*)(ws + WS_QN))
#define KN ((bf16_t*)(ws + WS_KN))
#define YATTN ((bf16_t*)(ws + WS_YATTN))
#define MF ((float*)(ws + WS_MF))
#define MB ((bf16_t*)(ws + WS_MB))
#define H2 ((bf16_t*)(ws + WS_H2))
#define PP ((bf16_t*)(ws + WS_PP))
#define VT ((bf16_t*)(ws + WS_VT))
#define XT ((bf16_t*)(ws + WS_XT))
#define BT ((bf16_t*)(ws + WS_BT))
#define OG ((bf16_t*)(ws + WS_OG))
#define LSE ((float*)(ws + WS_LSE))
#define SSQ ((float*)(ws + WS_SS))

constexpr int I_IN = 16 * 641, I_SQ = 16 * 64, I_BA = 4 * 64, I_PW = 4 * 16, I_PP = 2 * 64;
constexpr int I_LAYER = I_IN + 4 * I_SQ + I_BA + 4 * I_PW + I_PP;
__device__ __forceinline__ void convert_weight_item(const Params& P, unsigned char* ws, int L, int r, LAS float* scr, int lane) {
    if (r < I_IN) { transpose_item(P.in[I_W_IN] + (size_t)L * DM * NIN, DM, NIN, WT_IN + (size_t)L * WT_IN_STRIDE, 1, scr, r, lane, P.in[I_NORM_G] + L * DM); return; } r -= I_IN;
    if (r < I_SQ) { transpose_item(P.in[I_W_BR_SSD] + (size_t)L * DM * DM, DM, DM, WT_BRSSD + (size_t)L * DM * DM, 0, scr, r, lane, P.in[I_SSD_NORM_G] + L * DM); return; } r -= I_SQ;
    if (r < I_SQ) { transpose_item(P.in[I_W_BR_POOL] + (size_t)L * DM * DM, DM, DM, WT_BRPOOL + (size_t)L * DM * DM, 0, scr, r, lane); return; } r -= I_SQ;
    if (r < I_SQ) { transpose_item(P.in[I_W_OUT] + (size_t)L * DM * DM, DM, DM, WT_OUT + (size_t)L * DM * DM, 0, scr, r, lane); return; } r -= I_SQ;
    if (r < I_SQ) { transpose_item(P.in[I_W_PLE_GATE] + (size_t)L * DM * DM, DM, DM, WT_GATE + (size_t)L * DM * DM, 0, scr, r, lane, P.in[I_PLE_NORM_G] + L * DM); return; } r -= I_SQ;
    if (r < I_BA) { transpose_item(P.in[I_W_BR_ATTN] + (size_t)L * 512 * DM, 512, DM, WT_BRATTN + (size_t)L * 512 * DM, 0, scr, r, lane); return; } r -= I_BA;
    if (r < 4 * I_PW) { const int g = r / I_PW; transpose_item(P.in[I_POOL_W] + (size_t)(L * 4 + g) * 512 * 512, 512, 512, WT_POOL + (size_t)(L * 4 + g) * 512 * 512, 0, scr, r - g * I_PW, lane); return; } r -= 4 * I_PW;
    transpose_item(P.in[I_W_PLE_PROJ] + (size_t)L * PLE * DM, PLE, DM, WT_PROJ + (size_t)L * PLE * DM, 0, scr, r, lane);
}

template <int W> __device__ __forceinline__ void pooled_run(const bf16_t* up, bf16_t* outp, int m0, int t0) {
    u32x4 xr[15 + W];
#pragma unroll
    for (int q = 0; q < 15 + W; ++q) { const int dt_ = q - (W - 1);
        xr[q] = (t0 + dt_ >= 0) ? *(const u32x4*)(up + (size_t)(m0 + dt_) * NP) : (u32x4){0u, 0u, 0u, 0u}; }
    float s[8];
#pragma unroll
    for (int e = 0; e < 8; ++e) s[e] = 0.f;
#pragma unroll
    for (int q = 0; q < W - 1; ++q) { const u32x4 x = xr[q];
        s[0] += bflo(x.x); s[1] += bfhi(x.x); s[2] += bflo(x.y); s[3] += bfhi(x.y); s[4] += bflo(x.z); s[5] += bfhi(x.z); s[6] += bflo(x.w); s[7] += bfhi(x.w); }
#pragma unroll
    for (int i = 0; i < 16; ++i) { const u32x4 x = xr[i + W - 1]; const int t = t0 + i;
        s[0] += bflo(x.x); s[1] += bfhi(x.x); s[2] += bflo(x.y); s[3] += bfhi(x.y); s[4] += bflo(x.z); s[5] += bfhi(x.z); s[6] += bflo(x.w); s[7] += bfhi(x.w);
        const int cnt = (t + 1 < W) ? (t + 1) : W; const float ic = 1.f / (float)cnt;
        u32x4 o; o.x = cvt_pk_bf16(s[0] * ic - bflo(x.x), s[1] * ic - bfhi(x.x)); o.y = cvt_pk_bf16(s[2] * ic - bflo(x.y), s[3] * ic - bfhi(x.y));
        o.z = cvt_pk_bf16(s[4] * ic - bflo(x.z), s[5] * ic - bfhi(x.z)); o.w = cvt_pk_bf16(s[6] * ic - bflo(x.w), s[7] * ic - bfhi(x.w));
        *(u32x4*)(outp + (size_t)i * 512) = o;
        const u32x4 y = xr[i];
        s[0] -= bflo(y.x); s[1] -= bfhi(y.x); s[2] -= bflo(y.y); s[3] -= bfhi(y.y); s[4] -= bflo(y.z); s[5] -= bfhi(y.z); s[6] -= bflo(y.w); s[7] -= bfhi(y.w); }
}

__device__ __forceinline__ void dt_partial_item(const bf16_t* Hp, const bf16_t* Wdt, float* DTPp, int item, int lane) {
    const int mt = item >> 3, kq = item & 7, qc = lane & 31, hh = lane >> 5;
    const bf16_t* ap = Hp + (size_t)(mt * 32 + qc) * DM + kq * 256 + hh * 8;
    const bf16_t* bp = Wdt + (size_t)qc * DM + kq * 256 + hh * 8;
    bf16x8 af[16], bfv[16];
#pragma unroll
    for (int ks = 0; ks < 16; ++ks) { af[ks] = *(const bf16x8*)(ap + ks * 16); bfv[ks] = *(const bf16x8*)(bp + ks * 16); }
    f32x16 acc;
#pragma unroll
    for (int i = 0; i < 16; ++i) acc[i] = 0.f;
#pragma unroll
    for (int ks = 0; ks < 16; ++ks) acc = MFMA32(af[ks], bfv[ks], acc);
#pragma unroll
    for (int i = 0; i < 16; ++i) { const int row = (i & 3) + 8 * (i >> 2) + 4 * hh; DTPp[((size_t)kq * MTOK + mt * 32 + row) * 32 + qc] = acc[i]; }
}

__global__ void __launch_bounds__(512, 2) mega_fwd(Params P) {
    extern __shared__ __attribute__((aligned(16))) unsigned char lds_raw[];
    cg::grid_group grid = cg::this_grid();
    LAS unsigned char* lds = (LAS unsigned char*)lds_raw;
    const int G = gridDim.x, bx = blockIdx.x, NGW = G * 8, NGT = G * 512;
    if (threadIdx.x < 2) ((LAS unsigned*)(lds + 147456))[threadIdx.x] = 0u;
    __syncthreads();
    (void)xcd_barrier_post((unsigned*)(P.ws + WS_BAR), (volatile LAS unsigned*)(lds + 147456));
#define GSYNC() do { XcdBarrier xb_; xb_.bar = (unsigned*)(P.ws + WS_BAR); xb_.x = xb_xcc_id(); xb_.st = (volatile LAS unsigned*)(lds + 147456); xcd_barrier(xb_); } while (0)
#define PHASE_BEGIN unsigned char* ws = P.ws; asm volatile("" : "+s"(ws)); int tid = threadIdx.x; asm volatile("" : "+v"(tid)); \
    const int lane = tid & 63, wave = __builtin_amdgcn_readfirstlane(tid >> 6), gw = bx * 8 + wave, gt = bx * 512 + tid; (void)lane; (void)gw; (void)gt; (void)ws;

    REP(1) { PHASE_BEGIN
        LAS float* scr = (LAS float*)(lds + wave * 16384);
        for (int it = gw; it < 2 * I_LAYER; it += NGW) convert_weight_item(P, ws, it / I_LAYER, it % I_LAYER, scr, lane);
        for (int i = gt; i < 2 * MTOK * PLE / 8; i += NGT) { const f32x4 a = *(const f32x4*)(P.in[I_P] + (size_t)i * 8), b = *(const f32x4*)(P.in[I_P] + (size_t)i * 8 + 4);
            u32x4 w; w.x = cvt_pk_bf16(a[0], a[1]); w.y = cvt_pk_bf16(a[2], a[3]); w.z = cvt_pk_bf16(b[0], b[1]); w.w = cvt_pk_bf16(b[2], b[3]);
            *(u32x4*)(PBF + (size_t)i * 8) = w; }
        for (int m = gw; m < MTOK; m += NGW) row_to_bf16_ss(P.in[I_X] + (size_t)m * DM, H + (size_t)m * DM, SSQ + m, lane);
        for (int i = gt; i < 5 * MTOK; i += NGT) SSQ[MTOK + i] = 0.f;
    }
    GSYNC();
    if (gridDim.x == 0x7fffffffu) grid.sync();
    if (EXP == 6) { for (int q = 0; q < 10; ++q) GSYNC(); }

#pragma unroll 1
    for (int L = 0; L < 2; ++L) {
        REP(2) { PHASE_BEGIN
          pg8::Gemm g{H, WT_IN + (size_t)L * WT_IN_STRIDE, MTOK, 20480, DM}; pg8::StaticOrder S; S.init(MTOK, 20480, G, bx);
          pg8::EpiBf16 E{PROJ, NP, SSQ + (size_t)L * MTOK}; pg8::gemm_phase<pg8::EpiBf16, pg8::StaticOrder>(lds, g, S, E, nullptr);
          for (int it = gw; it < 2048; it += NGW) dt_partial_item(H, WT_IN + (size_t)L * WT_IN_STRIDE + (size_t)C_DT * DM, DTP, it, lane);
        }
        GSYNC();

        REP(3) { PHASE_BEGIN
            const float* cw = P.in[I_CONV_W] + (size_t)L * 4 * CONVC; const float* cb = P.in[I_CONV_B] + (size_t)L * CONVC;
            REP(12) for (int it = gw; it < 256 * 24; it += NGW) {
                const int mt = it / 24, ct = it - mt * 24, m0 = mt * 32, c0 = ct * 128, bb = m0 >> 11, t0 = m0 & (SEQ - 1);
                LAS bf16_t* tile = (LAS bf16_t*)(lds + wave * 16384);
                const int chunk = lane & 15, c = c0 + chunk * 8;
                const f32x4 bi0 = *(const f32x4*)(cb + c), bi1 = *(const f32x4*)(cb + c + 4);
                f32x4 wa[4], wb[4];
#pragma unroll
                for (int k = 0; k < 4; ++k) { wa[k] = *(const f32x4*)(cw + k * CONVC + c); wb[k] = *(const f32x4*)(cw + k * CONVC + c + 4); }
                const int rg = lane >> 4;
                u32x4 xin[11];
#pragma unroll
                for (int q = 0; q < 11; ++q) { const int tt = t0 + rg * 8 - 3 + q;
                    xin[q] = (tt >= 0) ? *(const u32x4*)(PROJ + (size_t)(m0 + rg * 8 - 3 + q) * NP + C_XBC + c) : (u32x4){0u, 0u, 0u, 0u}; }
#pragma unroll
                for (int i = 0; i < 8; ++i) { const int row = rg * 8 + i, m = m0 + row;
                    f32x4 a0 = bi0, a1 = bi1;
#pragma unroll
                    for (int k = 0; k < 4; ++k) { const u32x4 x = xin[i + k];
                        a0[0] += wa[k][0] * bflo(x.x); a0[1] += wa[k][1] * bfhi(x.x); a0[2] += wa[k][2] * bflo(x.y); a0[3] += wa[k][3] * bfhi(x.y);
                        a1[0] += wb[k][0] * bflo(x.z); a1[1] += wb[k][1] * bfhi(x.z); a1[2] += wb[k][2] * bflo(x.w); a1[3] += wb[k][3] * bfhi(x.w); }
                    u32x4 w; w.x = cvt_pk_bf16(siluf_(a0[0]), siluf_(a0[1])); w.y = cvt_pk_bf16(siluf_(a0[2]), siluf_(a0[3]));
                    w.z = cvt_pk_bf16(siluf_(a1[0]), siluf_(a1[1])); w.w = cvt_pk_bf16(siluf_(a1[2]), siluf_(a1[3]));
                    (void)m;
                    if (ct >= 16) { const int gI = (ct - 16) & 3; bf16_t* fb = (ct < 20) ? BF : CF;
                        *(u32x4*)(fb + ((size_t)((((bb * 32 + (t0 >> 6)) * 4 + gI) * 2 + (mt & 1)) * 8 + (chunk >> 1))) * 512 + ((chunk & 1) * 32 + row) * 8) = w; }
                    if (ct < 20) *(LAS u32x4*)(tile + row * 136 + chunk * 8) = w; }
                if (ct < 20) { LDS_WAIT(); asm volatile("" ::: "memory");
                    const int bc = bb * 32 + (t0 >> 6);
                    if (ct < 16) wave_tile_transpose_store_frag<4>(tile, XT, bc * 64 + (c0 >> 5), mt & 1, lane);
                    else wave_tile_transpose_store_frag<4>(tile, BT, (bc * 4 + (ct - 16)) * 4, mt & 1, lane);
                    LDS_WAIT(); asm volatile("" ::: "memory"); }
            }
            REP(14) for (int it = gw; it < 4 * 12 * 64; it += NGW) {
                const int bb = it / 768, rem = it - bb * 768, head = rem >> 6, pb = rem & 63, sh = 2 * (head >> 2), dil = 1 << sh, ld = SEQ >> sh;
                const int pos0 = pb * 32, r = pos0 >> (11 - sh), s0 = pos0 & (ld - 1), chunk = lane & 15;
                LAS bf16_t* tile = (LAS bf16_t*)(lds + wave * 16384);
#pragma unroll
                for (int i = 0; i < 8; ++i) { const int row = i * 4 + (lane >> 4); const size_t m = (size_t)bb * SEQ + (size_t)(s0 + row) * dil + r;
                    *(LAS u32x4*)(tile + row * 136 + chunk * 8) = *(const u32x4*)(PROJ + m * NP + C_V + head * 128 + chunk * 8); }
                LDS_WAIT(); asm volatile("" ::: "memory");
                wave_tile_transpose_store_frag<2>(tile, VT, ((bb * 12 + head) * 64 + pb) * 4, 0, lane);
                LDS_WAIT(); asm volatile("" ::: "memory");
            }
            REP(18) for (int it = gw; it < 128 * 8; it += NGW) { const int m = (it >> 3) * 64 + lane;
#pragma unroll 2
                for (int h = (it & 7) * 4; h < (it & 7) * 4 + 4; ++h) {
                    float rawp = 0.f;
#pragma unroll
                    for (int kq = 0; kq < 8; ++kq) rawp += DTP[((size_t)kq * MTOK + m) * 32 + h];
                    const float raw = P.in[I_DT_BIAS][L * 32 + h] + rawp * rsqrtf(SSQ[(size_t)L * MTOK + m] * (1.f / 2048.f) + RMS_EPS);
                    const float dt = fmaxf(raw, 0.f) + __logf(1.f + __expf(-fabsf(raw)));
                    float cum = -dt * __expf(P.in[I_A_LOG][L * 32 + h]);
#pragma unroll
                    for (int o = 1; o < 64; o <<= 1) { const float v = __shfl_up(cum, o); if (lane >= o) cum += v; }
                    DT[(size_t)m * 32 + h] = dt; DA[(size_t)m * 32 + h] = cum * 1.4426950408889634f; } }
            REP(13) for (int it = gw; it < 512 * 4; it += NGW) {
                const int run = it >> 2, g = it & 3, m0 = run * 16, t0 = m0 & (SEQ - 1);
                const bf16_t* up = PROJ + C_UPOOL + g * 512 + lane * 8; bf16_t* outp = POOLED + ((size_t)g * MTOK + m0) * 512 + lane * 8;
                if (g == 0) pooled_run<2>(up, outp, m0, t0); else if (g == 1) pooled_run<4>(up, outp, m0, t0); else if (g == 2) pooled_run<8>(up, outp, m0, t0); else pooled_run<16>(up, outp, m0, t0);
            }
            REP(15) for (int tg = gw; tg < MTOK / 4; tg += NGW) {
                const int m = tg * 4 + (lane >> 4), d = (lane & 15) * 8, tq = m & (SEQ - 1), gr = lane & 15;
#pragma unroll 1
                for (int hb = 0; hb < 24; hb += 8) {
                    u32x4 xq[8];
#pragma unroll
                    for (int u = 0; u < 8; ++u) { const int hh = hb + u, isk = (hh >= 12) ? 1 : 0, head = hh - 12 * isk;
                        xq[u] = *(const u32x4*)(PROJ + (size_t)m * NP + (isk ? C_K : C_Q) + head * 128 + d); }
#pragma unroll
                    for (int u = 0; u < 8; ++u) { const int hh = hb + u, isk = (hh >= 12) ? 1 : 0, head = hh - 12 * isk;
                        const u32x4 x = xq[u];
                        const float f0 = bflo(x.x), f1 = bfhi(x.x), f2 = bflo(x.y), f3 = bfhi(x.y), f4 = bflo(x.z), f5 = bfhi(x.z), f6 = bflo(x.w), f7 = bfhi(x.w);
                        float ss = (f0 * f0 + f1 * f1) + (f2 * f2 + f3 * f3) + (f4 * f4 + f5 * f5) + (f6 * f6 + f7 * f7);
                        ss += __shfl_xor(ss, 1); ss += __shfl_xor(ss, 2); ss += __shfl_xor(ss, 4); ss += __shfl_xor(ss, 8);
                        const float rinv = rsqrtf(ss * (1.f / 128.f) + RMS_EPS);
                        const float* gg = (isk ? P.in[I_K_NORM_G] : P.in[I_Q_NORM_G]) + L * 128 + d;
                        const f32x4 g0 = *(const f32x4*)gg, g1 = *(const f32x4*)(gg + 4);
                        u32x4 o; o.x = cvt_pk_bf16(f0 * rinv * g0[0], f1 * rinv * g0[1]); o.y = cvt_pk_bf16(f2 * rinv * g0[2], f3 * rinv * g0[3]);
                        o.z = cvt_pk_bf16(f4 * rinv * g1[0], f5 * rinv * g1[1]); o.w = cvt_pk_bf16(f6 * rinv * g1[2], f7 * rinv * g1[3]);
                        const int sh = 2 * (head >> 2), pos = ((tq & ((1 << sh) - 1)) << (11 - sh)) + (tq >> sh);
                        *(u32x4*)((isk ? KN : QN) + ((size_t)((((m >> 11) * 12 + head) * 64 + (pos >> 5)) * 8 + (gr >> 1))) * 512 + ((gr & 1) * 32 + (pos & 31)) * 8) = o; }
                }
            }
        }
        GSYNC();

        REP(4) { PHASE_BEGIN
            __syncthreads();
            REP(7) for (int item = bx; item < 128; item += G)
                ssd_block(lds, CF, BF, XT, BT, DT, DA, YSSD, PROJ + C_ZSSD, SSQ + (size_t)(4 + L) * MTOK, P.in[I_D_SKIP][L * 32 + (item & 31)], item >> 5, item & 31, tid);
            { const int nb0 = (G > 128) ? 128 : 0;
              REP(8) if (bx >= nb0) for (int it = (bx - nb0) * 8 + wave; it < 3072; it += (G - nb0) * 8) attn_item(QN, KN, VT, OG, LSE, it, lane); }
            __syncthreads();
            REP(9) { pg8::Gemm g{POOLED, WT_POOL + (size_t)L * 4 * 512 * 512, 4 * MTOK, 2048, 512}; pg8::PoolOrder S{(G > 128) ? G - 128 : G, (G > 128) ? ((bx >= 128) ? bx - 128 : 1000000) : bx};
              pg8::EpiPool E{YPOOL, PROJ + C_ZPOOL, NP, P.in[I_POOL_SCALE] + L * 2048};
              pg8::gemm_phase<pg8::EpiPool, pg8::PoolOrder>(lds, g, S, E, nullptr); }
            { pg8::Gemm g{PBF + (size_t)L * MTOK * PLE, WT_PROJ + (size_t)L * PLE * DM, MTOK, DM, PLE}; pg8::EpiBf16NP E{PP};
              pg8::StaticOrder S; S.init(MTOK, DM, (G > 128) ? G - 128 : G, (G > 128) ? ((bx >= 128) ? bx - 128 : (1 << 28)) : bx);
              pg8::gemm_phase<pg8::EpiBf16NP, pg8::StaticOrder>(lds, g, S, E, nullptr); }
            if (false) { const int nb0 = (G > 128) ? 128 : 0; LAS float* scr = (LAS float*)(lds + wave * 16384);
                if (bx >= nb0) for (int it = (bx - nb0) * 8 + wave; it < I_LAYER; it += (G - nb0) * 8) convert_weight_item(P, ws, 1, it, scr, lane); }
        }
        GSYNC();

        REP(5) { PHASE_BEGIN
        for (int m = gw; m < MTOK; m += NGW) { const int col = lane * 8, j = lane >> 4;
            const float l0 = LSE[((size_t)0 * MTOK + m) * 4 + j], l1 = LSE[((size_t)1 * MTOK + m) * 4 + j], l2 = LSE[((size_t)2 * MTOK + m) * 4 + j];
            const float lm = fmaxf(l0, fmaxf(l1, l2)); float w0 = __expf(l0 - lm), w1 = __expf(l1 - lm), w2 = __expf(l2 - lm); const float iw = 1.f / (w0 + w1 + w2); w0 *= iw; w1 *= iw; w2 *= iw;
            const u32x4 a = *(const u32x4*)(OG + ((size_t)0 * MTOK + m) * 512 + col), bq = *(const u32x4*)(OG + ((size_t)1 * MTOK + m) * 512 + col), cq = *(const u32x4*)(OG + ((size_t)2 * MTOK + m) * 512 + col);
            const u32x4 z = *(const u32x4*)(PROJ + (size_t)m * NP + C_ZATTN + col);
            u32x4 o;
            o.x = cvt_pk_bf16((w0 * bflo(a.x) + w1 * bflo(bq.x) + w2 * bflo(cq.x)) * siluf_(bflo(z.x)), (w0 * bfhi(a.x) + w1 * bfhi(bq.x) + w2 * bfhi(cq.x)) * siluf_(bfhi(z.x)));
            o.y = cvt_pk_bf16((w0 * bflo(a.y) + w1 * bflo(bq.y) + w2 * bflo(cq.y)) * siluf_(bflo(z.y)), (w0 * bfhi(a.y) + w1 * bfhi(bq.y) + w2 * bfhi(cq.y)) * siluf_(bfhi(z.y)));
            o.z = cvt_pk_bf16((w0 * bflo(a.z) + w1 * bflo(bq.z) + w2 * bflo(cq.z)) * siluf_(bflo(z.z)), (w0 * bfhi(a.z) + w1 * bfhi(bq.z) + w2 * bfhi(cq.z)) * siluf_(bfhi(z.z)));
            o.w = cvt_pk_bf16((w0 * bflo(a.w) + w1 * bflo(bq.w) + w2 * bflo(cq.w)) * siluf_(bflo(z.w)), (w0 * bfhi(a.w) + w1 * bfhi(bq.w) + w2 * bfhi(cq.w)) * siluf_(bfhi(z.w)));
            *(u32x4*)(YATTN + (size_t)m * 512 + col) = o; }
        }
        GSYNC();

        REP(10) { PHASE_BEGIN pg8::StaticOrder S; S.init(MTOK, DM, G, bx);
          pg8::Merge3 g{YSSD, YPOOL, YATTN, WT_BRSSD + (size_t)L * DM * DM, WT_BRPOOL + (size_t)L * DM * DM, WT_BRATTN + (size_t)L * 512 * DM, DM, DM, 512, PROJ + C_GATES, NP, MB, SSQ + (size_t)(4 + L) * MTOK};
          pg8::gemm_merge3<pg8::StaticOrder>(lds, g, S); }
        GSYNC();

        { PHASE_BEGIN pg8::StaticOrder S; S.init(MTOK, DM, G, bx);
          pg8::Gemm g{MB, WT_OUT + (size_t)L * DM * DM, MTOK, DM, DM};
          if (L == 0) { pg8::EpiResid<false> E{P.in[I_X], H, H2, SSQ + (size_t)2 * MTOK}; pg8::gemm_phase<pg8::EpiResid<false>, pg8::StaticOrder>(lds, g, S, E, nullptr); }
          else { pg8::EpiResid<true> E{P.in[I_X], H, H2, SSQ + (size_t)3 * MTOK}; pg8::gemm_phase<pg8::EpiResid<true>, pg8::StaticOrder>(lds, g, S, E, nullptr); } }
        GSYNC();

        { PHASE_BEGIN pg8::StaticOrder S; S.init(MTOK, DM, G, bx);
          pg8::Gemm g{H2, WT_GATE + (size_t)L * DM * DM, MTOK, DM, DM};
          if (L == 0) { pg8::EpiPle<true> E{PP, H2, P.out, SSQ + (size_t)2 * MTOK, H, SSQ + (size_t)MTOK}; pg8::gemm_phase<pg8::EpiPle<true>, pg8::StaticOrder>(lds, g, S, E, nullptr); }
          else { pg8::EpiPle<false> E{PP, H2, P.out, SSQ + (size_t)3 * MTOK, H, SSQ + (size_t)MTOK}; pg8::gemm_phase<pg8::EpiPle<false>, pg8::StaticOrder>(lds, g, S, E, nullptr); } }
        if (L == 0) GSYNC();
    }
}

extern "C" void kernel_launch(void* const* d_in, const int* in_sizes, int n_in, void* d_out, int out_size, void* d_ws, size_t ws_size, hipStream_t stream) {
    static int grid_blocks = 0;
    if (grid_blocks == 0) {
        if (n_in != 21 || out_size != MTOK * DM || ws_size < WS_END) { fprintf(stderr, "kernel_launch: unexpected shapes: n_in %d out %d ws %zu (need %zu)\n", n_in, out_size, ws_size, (size_t)WS_END); grid_blocks = -1; return; }
        int dev = 0, cus = 0, per_cu = 0;
        hipGetDevice(&dev);
        hipDeviceGetAttribute(&cus, hipDeviceAttributeMultiprocessorCount, dev);
        if (hipFuncSetAttribute((const void*)mega_fwd, hipFuncAttributeMaxDynamicSharedMemorySize, LDS_BYTES) != hipSuccess) { fprintf(stderr, "kernel_launch: hipFuncSetAttribute failed\n"); grid_blocks = -1; return; }
        if (hipOccupancyMaxActiveBlocksPerMultiprocessor(&per_cu, (const void*)mega_fwd, 512, LDS_BYTES) != hipSuccess || per_cu < 1) { fprintf(stderr, "kernel_launch: occupancy query gave %d\n", per_cu); per_cu = 1; (void)hipGetLastError(); }
        grid_blocks = cus * (per_cu > 1 ? 1 : per_cu);
    }
    if (grid_blocks < 0) return;
    if (hipMemsetAsync((char*)d_ws + WS_BAR, 0, 16384, stream) != hipSuccess) { fprintf(stderr, "kernel_launch: memset of the barrier words failed\n"); return; }
    Params p{};
    for (int i = 0; i < 21; ++i) p.in[i] = (const float*)d_in[i];
    p.out = (float*)d_out; p.ws = (unsigned char*)d_ws;
    void* args[] = {&p};
    hipError_t e = hipLaunchCooperativeKernel((const void*)mega_fwd, dim3(grid_blocks), dim3(512), args, LDS_BYTES, stream);
    if (e != hipSuccess) fprintf(stderr, "cooperative launch failed: %s (grid %d)\n", hipGetErrorString(e), grid_blocks);
}
```

```cpp
#include <hip/hip_runtime.h>
#include <hip/hip_cooperative_groups.h>
#include <cstdio>
namespace cg = cooperative_groups;
namespace pg8 {
#define PG8_LAS __attribute__((address_space(3)))
typedef unsigned short bf16_t;
typedef short bf16x8 __attribute__((ext_vector_type(8)));
typedef float f32x4 __attribute__((ext_vector_type(4)));
typedef unsigned u32x4 __attribute__((ext_vector_type(4)));
constexpr int BM = 256, BK = 64, HALF = 128, HTB = HALF * BK * 2  , STAGE_BYTES = 8 * HTB, NXCD = 8, WGM = 8;

__host__ __device__ __forceinline__ int lds_byte(int r, int c) { const int st = (r >> 4) * 2 + (c >> 5), rr = r & 15, cc = c & 31, ob = rr * 64 + cc * 2; return st * 1024 + (ob ^ (((ob >> 9) & 1) << 5)); }
__host__ __device__ __forceinline__ void stage_rc(int b, int& R, int& C) { const int st = b / 1024, sb = b % 1024, swz = sb ^ (((sb >> 9) & 1) << 5); R = (st >> 1) * 16 + swz / 64; C = (st & 1) * 32 + (swz % 64) / 2; }
__host__ __device__ __forceinline__ int perm32(int rho) { const int n = rho >> 4, i = rho & 15; return 8 * (i >> 2) + 4 * n + (i & 3); }

struct Unit { int pm, pn; };
struct Gemm { const bf16_t* A; const bf16_t* Bt; int M, N, K; };

struct StaticOrder {
    int nM, nN, nwg, G, c;
    __host__ __device__ void init(int M, int N, int G_, int c_) { nM = M / BM; nN = N / BM; nwg = nM * nN; G = G_; c = c_; }
    __host__ __device__ bool next(int i, Unit& u) const {
        const long L = (long)i * G + c; if (L >= nwg) return false;
        int wgid = (int)L; { const int q = nwg / NXCD, r = nwg % NXCD, xcd = wgid % NXCD, off = wgid / NXCD; wgid = (xcd < r ? xcd * (q + 1) : r * (q + 1) + (xcd - r) * q) + off; }
        const int nig = WGM * nN, gid = wgid / nig, fm = gid * WGM, gsz = (nM - fm) < WGM ? (nM - fm) : WGM;
        u.pm = fm + ((wgid % nig) % gsz); u.pn = (wgid % nig) / gsz; return true;
    }
    __device__ __forceinline__ void a_ready(const Unit&) const {}
    __device__ __forceinline__ void done(const Unit&) const {}
};
__device__ __forceinline__ unsigned cvt_pk_bf16(float lo, float hi) { unsigned r; asm volatile("v_cvt_pk_bf16_f32 %0, %1, %2" : "=v"(r) : "v"(lo), "v"(hi)); return r; }
typedef float f32x2 __attribute__((ext_vector_type(2)));
typedef unsigned u32x2 __attribute__((ext_vector_type(2)));
__device__ __forceinline__ float bf2f(unsigned short b) { return __uint_as_float(((unsigned)b) << 16); }
__device__ __forceinline__ float bflo(unsigned w) { return __uint_as_float(w << 16); }
__device__ __forceinline__ float bfhi(unsigned w) { return __uint_as_float(w & 0xffff0000u); }
__device__ __forceinline__ float sigmoidf_(float x) { return __builtin_amdgcn_rcpf(1.0f + __expf(-x)); }
__device__ __forceinline__ float siluf_(float x) { return x * __builtin_amdgcn_rcpf(1.0f + __expf(-x)); }

struct EpiF32 {
    static constexpr bool PERM = false, AFTER_DRAIN = false;
    float* C; int ldc;
    __device__ __forceinline__ void operator()(const f32x4 (&acc)[2][2][4][2], const Unit& u, int wr, int wc, int fr, int fq) const {
        const int row0 = u.pm * BM + wr * 64 + fr, col0 = u.pn * BM + wc * 32 + 4 * fq;
#pragma unroll
        for (int ai = 0; ai < 2; ++ai)
#pragma unroll
            for (int m = 0; m < 4; ++m) { float* rowp = C + (size_t)(row0 + ai * HALF + m * 16) * ldc + col0;
#pragma unroll
                for (int bj = 0; bj < 2; ++bj)
#pragma unroll
                    for (int n = 0; n < 2; ++n) *(f32x4*)(rowp + bj * HALF + n * 16) = acc[ai][bj][m][n]; }
    }
};
struct EpiBf16 {
    static constexpr bool PERM = true, AFTER_DRAIN = false;
    bf16_t* O; int ldc; const float* SS;
    __device__ __forceinline__ void operator()(const f32x4 (&acc)[2][2][4][2], const Unit& u, int wr, int wc, int fr, int fq) const {
        const int row0 = u.pm * BM + wr * 64 + fr; const int col0 = u.pn * BM + wc * 32 + 8 * fq;
#pragma unroll
        for (int ai = 0; ai < 2; ++ai)
#pragma unroll
            for (int m = 0; m < 4; ++m) { const int row = row0 + ai * HALF + m * 16; bf16_t* rowp = O + (size_t)row * ldc + col0;
                const float ri = rsqrtf(SS[row] * (1.f / 2048.f) + 1e-6f);
#pragma unroll
                for (int bj = 0; bj < 2; ++bj) { const f32x4 v0 = acc[ai][bj][m][0] * ri, v1 = acc[ai][bj][m][1] * ri;
                    u32x4 w; w.x = cvt_pk_bf16(v0[0], v0[1]); w.y = cvt_pk_bf16(v0[2], v0[3]); w.z = cvt_pk_bf16(v1[0], v1[1]); w.w = cvt_pk_bf16(v1[2], v1[3]);
                    *(u32x4*)(rowp + bj * HALF) = w; } }
    }
};
struct EpiPool {
    static constexpr bool PERM = true, AFTER_DRAIN = false;
    bf16_t* O; const bf16_t* Z; int ldz; const float* scale;
    __device__ __forceinline__ void operator()(const f32x4 (&acc)[2][2][4][2], const Unit& u, int wr, int wc, int fr, int fq) const {
        const int row0 = (u.pm & 31) * BM + wr * 64 + fr; const int col0 = u.pn * BM + wc * 32 + 8 * fq;
#pragma unroll
        for (int bj = 0; bj < 2; ++bj) {
            const f32x4 s0 = *(const f32x4*)(scale + col0 + bj * HALF), s1 = *(const f32x4*)(scale + col0 + bj * HALF + 4);
#pragma unroll
            for (int ai = 0; ai < 2; ++ai)
#pragma unroll
                for (int m = 0; m < 4; ++m) { const size_t row = (size_t)(row0 + ai * HALF + m * 16);
                    const u32x4 z = *(const u32x4*)(Z + row * ldz + col0 + bj * HALF);
                    const f32x4 v0 = acc[ai][bj][m][0], v1 = acc[ai][bj][m][1];
                    u32x4 w;
                    w.x = cvt_pk_bf16(v0[0] * s0[0] * siluf_(bflo(z.x)), v0[1] * s0[1] * siluf_(bfhi(z.x)));
                    w.y = cvt_pk_bf16(v0[2] * s0[2] * siluf_(bflo(z.y)), v0[3] * s0[3] * siluf_(bfhi(z.y)));
                    w.z = cvt_pk_bf16(v1[0] * s1[0] * siluf_(bflo(z.z)), v1[1] * s1[1] * siluf_(bfhi(z.z)));
                    w.w = cvt_pk_bf16(v1[2] * s1[2] * siluf_(bflo(z.w)), v1[3] * s1[3] * siluf_(bfhi(z.w)));
                    *(u32x4*)(O + row * 2048 + col0 + bj * HALF) = w; } }
    }
};
template <int MODE> struct EpiMerge {
    static constexpr bool PERM = false, AFTER_DRAIN = false;
    const bf16_t* GL; int ldg; float* MF; bf16_t* MB;
    __device__ __forceinline__ void operator()(const f32x4 (&acc)[2][2][4][2], const Unit& u, int wr, int wc, int fr, int fq) const {
        const int row0 = u.pm * BM + wr * 64 + fr, col0 = u.pn * BM + wc * 32 + 4 * fq;
#pragma unroll
        for (int ai = 0; ai < 2; ++ai)
#pragma unroll
            for (int m = 0; m < 4; ++m) { const size_t row = (size_t)(row0 + ai * HALF + m * 16);
#pragma unroll
                for (int bj = 0; bj < 2; ++bj)
#pragma unroll
                    for (int n = 0; n < 2; ++n) { const int col = col0 + bj * HALF + n * 16;
                        const u32x2 g = *(const u32x2*)(GL + row * ldg + col);
                        f32x4 v = acc[ai][bj][m][n];
                        v[0] *= sigmoidf_(bflo(g.x)); v[1] *= sigmoidf_(bfhi(g.x)); v[2] *= sigmoidf_(bflo(g.y)); v[3] *= sigmoidf_(bfhi(g.y));
                        if (MODE >= 1) v += *(const f32x4*)(MF + row * 2048 + col);
                        if (MODE < 2) *(f32x4*)(MF + row * 2048 + col) = v;
                        else { u32x2 w; w.x = cvt_pk_bf16(v[0], v[1]); w.y = cvt_pk_bf16(v[2], v[3]); *(u32x2*)(MB + row * 2048 + col) = w; } } }
    }
};
template <bool XBF> struct EpiResid {
    static constexpr bool PERM = false, AFTER_DRAIN = false;
    const float* XIN; const bf16_t* XINB; bf16_t* XB; float* SSo;
    __device__ __forceinline__ void operator()(const f32x4 (&acc)[2][2][4][2], const Unit& u, int wr, int wc, int fr, int fq) const {
        const int row0 = u.pm * BM + wr * 64 + fr, col0 = u.pn * BM + wc * 32 + 4 * fq;
#pragma unroll
        for (int ai = 0; ai < 2; ++ai)
#pragma unroll
            for (int m = 0; m < 4; ++m) { const size_t row = (size_t)(row0 + ai * HALF + m * 16); float ss = 0.f;
#pragma unroll
                for (int bj = 0; bj < 2; ++bj)
#pragma unroll
                    for (int n = 0; n < 2; ++n) { const size_t idx = row * 2048 + col0 + bj * HALF + n * 16;
                        f32x4 xi;
                        if (XBF) { const u32x2 xw = *(const u32x2*)(XINB + idx); xi = (f32x4){bflo(xw.x), bfhi(xw.x), bflo(xw.y), bfhi(xw.y)}; } else xi = *(const f32x4*)(XIN + idx);
                        const f32x4 o = xi + acc[ai][bj][m][n];
                        u32x2 w; w.x = cvt_pk_bf16(o[0], o[1]); w.y = cvt_pk_bf16(o[2], o[3]); *(u32x2*)(XB + idx) = w;
                        const float r0 = bflo(w.x), r1 = bfhi(w.x), r2 = bflo(w.y), r3 = bfhi(w.y);
                        ss += (r0 * r0 + r1 * r1) + (r2 * r2 + r3 * r3); }
                ss += __shfl_xor(ss, 16); ss += __shfl_xor(ss, 32);
                if (fq == 0) unsafeAtomicAdd(SSo + row, ss); }
    }
};
template <bool NEXT> struct EpiPle {
    static constexpr bool PERM = false, AFTER_DRAIN = false;
    const float* PP; const bf16_t* X1B; float* OUT; const float* SSi; bf16_t* XB; float* SSo;
    __device__ __forceinline__ void operator()(const f32x4 (&acc)[2][2][4][2], const Unit& u, int wr, int wc, int fr, int fq) const {
        const int row0 = u.pm * BM + wr * 64 + fr, col0 = u.pn * BM + wc * 32 + 4 * fq;
#pragma unroll
        for (int ai = 0; ai < 2; ++ai)
#pragma unroll
            for (int m = 0; m < 4; ++m) { const size_t row = (size_t)(row0 + ai * HALF + m * 16); float ss = 0.f;
                const float ri = rsqrtf(SSi[row] * (1.f / 2048.f) + 1e-6f);
#pragma unroll
                for (int bj = 0; bj < 2; ++bj)
#pragma unroll
                    for (int n = 0; n < 2; ++n) { const size_t idx = row * 2048 + col0 + bj * HALF + n * 16;
                        const f32x4 a = acc[ai][bj][m][n] * ri, pp = *(const f32x4*)(PP + idx); const u32x2 xw = *(const u32x2*)(X1B + idx);
                        f32x4 o = {bflo(xw.x), bfhi(xw.x), bflo(xw.y), bfhi(xw.y)};
                        o[0] += sigmoidf_(a[0]) * pp[0]; o[1] += sigmoidf_(a[1]) * pp[1]; o[2] += sigmoidf_(a[2]) * pp[2]; o[3] += sigmoidf_(a[3]) * pp[3];
                        if (NEXT) { u32x2 w; w.x = cvt_pk_bf16(o[0], o[1]); w.y = cvt_pk_bf16(o[2], o[3]); *(u32x2*)(XB + idx) = w;
                            const float r0 = bflo(w.x), r1 = bfhi(w.x), r2 = bflo(w.y), r3 = bfhi(w.y);
                            ss += (r0 * r0 + r1 * r1) + (r2 * r2 + r3 * r3); }
                        else *(f32x4*)(OUT + idx) = o; }
                if (NEXT) { ss += __shfl_xor(ss, 16); ss += __shfl_xor(ss, 32); if (fq == 0) unsafeAtomicAdd(SSo + row, ss); } }
    }
};
struct PoolOrder {
    int G, c;
    __device__ bool next(int i, Unit& u) const {
        const int L = i * G + c; if (L >= 256) return false;
        const int g = L >> 6, rem = L & 63, mt = rem >> 1, nt = rem & 1;
        u.pm = g * 32 + mt; u.pn = g * 2 + nt; return true;
    }
    __device__ __forceinline__ void a_ready(const Unit&) const {}
    __device__ __forceinline__ void done(const Unit&) const {}
};
template <class Epi, class Sched, bool STAMP = false>
__device__ __forceinline__ void gemm_phase(PG8_LAS unsigned char* lds, const Gemm g, const Sched& S, const Epi& E, unsigned long long* stamps) {
    int tid_ = threadIdx.x; asm volatile("" : "+v"(tid_));
    const int tid = tid_, wid = __builtin_amdgcn_readfirstlane(tid >> 6), lane = tid & 63, wr = wid >> 2, wc = wid & 3, fr = lane & 15, fq = lane >> 4;
    const int K = g.K, nt = K / BK;
    int ts_lo = 0, ts_hi = 0, nts = 0; const unsigned long long rt_entry = STAMP ? (unsigned long long)wall_clock64() : 0ull;
#define PG8_STAMP() do { if (STAMP && wid == 0 && nts < 64) { const unsigned long long _c = (unsigned long long)clock64(); \
        ts_lo = (lane == nts) ? (int)(unsigned)_c : ts_lo; ts_hi = (lane == nts) ? (int)(unsigned)(_c >> 32) : ts_hi; ++nts; } } while (0)
    PG8_STAMP();
    unsigned voffA[2], voffB[2];
#pragma unroll
    for (int i = 0; i < 2; ++i) { int R, C; stage_rc(tid * 16 + i * 8192, R, C); const int Rb = Epi::PERM ? ((R & ~31) + perm32(R & 31)) : R;
        voffA[i] = (unsigned)(R * K + C) * 2u; voffB[i] = (unsigned)(Rb * K + C) * 2u; }
    const size_t kstep = (size_t)(BK * 2);
    const size_t hstep = (size_t)HALF * K * 2;
    const size_t tstep = 2 * hstep;
    const unsigned ldsw = (unsigned)wid * 1024u;
    const int aoff = lds_byte(wr * 64 + fr, fq * 8), boff = lds_byte(wc * 32 + fr, fq * 8);
#define PG8_SA(b, h) (((b) * 2 + (h)) * HTB)
#define PG8_SB(b, h) ((4 + (b) * 2 + (h)) * HTB)
#define PG8_STAGE(bufoff, gbase, voff) do { _Pragma("unroll") for (int _i = 0; _i < 2; ++_i) \
        __builtin_amdgcn_global_load_lds((const unsigned*)((const char*)(gbase) + (voff)[_i]), (PG8_LAS unsigned*)(lds + (bufoff) + ldsw + _i * 8192), 16, 0, 0); } while (0)
#define PG8_LDA(dst, b, h) do { _Pragma("unroll") for (int m = 0; m < 4; ++m) _Pragma("unroll") for (int k = 0; k < 2; ++k) dst[m][k] = *(const PG8_LAS bf16x8*)(lds + PG8_SA(b, h) + aoff + m * 2048 + k * 1024); } while (0)
#define PG8_LDB(dst, b, h) do { _Pragma("unroll") for (int n = 0; n < 2; ++n) _Pragma("unroll") for (int k = 0; k < 2; ++k) dst[n][k] = *(const PG8_LAS bf16x8*)(lds + PG8_SB(b, h) + boff + n * 2048 + k * 1024); } while (0)
#define PG8_MMA(ai, bj, At, Bt) do { __builtin_amdgcn_s_setprio(1); _Pragma("unroll") for (int m = 0; m < 4; ++m) _Pragma("unroll") for (int n = 0; n < 2; ++n) _Pragma("unroll") for (int k = 0; k < 2; ++k) \
        acc[ai][bj][m][n] = __builtin_amdgcn_mfma_f32_16x16x32_bf16(Bt[n][k], At[m][k], acc[ai][bj][m][n], 0, 0, 0); __builtin_amdgcn_s_setprio(0); } while (0)
#define PG8_WAIT_V(n) asm volatile("s_waitcnt vmcnt(" #n ")" ::: "memory")
#define PG8_WAIT_L(n) asm volatile("s_waitcnt lgkmcnt(" #n ")" ::: "memory")
#define PG8_BAR __builtin_amdgcn_s_barrier()
#define PG8_SCHED __builtin_amdgcn_sched_barrier(0)
    Unit cur, nxt; int ui = 0;
    if (!S.next(0, cur)) return;
    f32x4 acc[2][2][4][2];
#pragma unroll
    for (int a = 0; a < 2; ++a)
#pragma unroll
        for (int b = 0; b < 2; ++b)
#pragma unroll
            for (int m = 0; m < 4; ++m)
#pragma unroll
                for (int n = 0; n < 2; ++n) acc[a][b][m][n] = (f32x4){0.f, 0.f, 0.f, 0.f};
    bf16x8 At[4][2], B0[2][2], B1[2][2];
    const char* cA = (const char*)g.A + (size_t)cur.pm * tstep; const char* cB = (const char*)g.Bt + (size_t)cur.pn * tstep;
    S.a_ready(cur);
    PG8_STAGE(PG8_SB(0, 0), cB, voffB); PG8_STAGE(PG8_SA(0, 0), cA, voffA); PG8_STAGE(PG8_SB(0, 1), cB + hstep, voffB); PG8_STAGE(PG8_SA(0, 1), cA + hstep, voffA);
    if (wr == 1) PG8_BAR;
    PG8_WAIT_V(4); PG8_BAR;
    PG8_STAGE(PG8_SB(1, 0), cB + kstep, voffB); PG8_STAGE(PG8_SA(1, 0), cA + kstep, voffA); PG8_STAGE(PG8_SB(1, 1), cB + hstep + kstep, voffB);
    PG8_WAIT_V(6); PG8_BAR;
    PG8_STAMP();
    for (;;) {
        const bool has_next = S.next(ui + 1, nxt);
        const char* nA = has_next ? (const char*)g.A + (size_t)nxt.pm * tstep : cA; const char* nB = has_next ? (const char*)g.Bt + (size_t)nxt.pn * tstep : cB;
        for (int t = 0; t < nt; t += 2) {
            const bool last = (t == nt - 2);
            const char* a1 = cA + (size_t)(t + 1) * kstep;
            const char* a2 = last ? nA : cA + (size_t)(t + 2) * kstep; const char* b2 = last ? nB : cB + (size_t)(t + 2) * kstep;
            const char* a3 = a2 + kstep; const char* b3 = b2 + kstep;
            if (last && has_next) S.a_ready(nxt);
            PG8_LDB(B0, 0, 0); PG8_SCHED; PG8_LDA(At, 0, 0); PG8_STAGE(PG8_SA(1, 1), a1 + hstep, voffA);
            PG8_WAIT_L(8); PG8_BAR; PG8_WAIT_L(0); PG8_MMA(0, 0, At, B0); PG8_BAR; PG8_SCHED;
            PG8_LDB(B1, 0, 1); PG8_STAGE(PG8_SB(0, 0), b2, voffB);
            PG8_BAR; PG8_WAIT_L(0); PG8_MMA(0, 1, At, B1); PG8_BAR;
            PG8_LDA(At, 0, 1); PG8_STAGE(PG8_SA(0, 0), a2, voffA);
            PG8_BAR; PG8_WAIT_L(0); PG8_MMA(1, 0, At, B0); PG8_BAR; PG8_SCHED;
            PG8_STAGE(PG8_SB(0, 1), b2 + hstep, voffB);
            PG8_WAIT_V(6); PG8_BAR; PG8_MMA(1, 1, At, B1); PG8_BAR;
            PG8_LDB(B0, 1, 0); PG8_SCHED; PG8_LDA(At, 1, 0); PG8_STAGE(PG8_SA(0, 1), a2 + hstep, voffA);
            PG8_WAIT_L(8); PG8_BAR; PG8_WAIT_L(0); PG8_MMA(0, 0, At, B0); PG8_BAR; PG8_SCHED;
            PG8_LDB(B1, 1, 1); PG8_STAGE(PG8_SB(1, 0), b3, voffB);
            PG8_BAR; PG8_WAIT_L(0); PG8_MMA(0, 1, At, B1); PG8_BAR;
            PG8_LDA(At, 1, 1); PG8_STAGE(PG8_SA(1, 0), a3, voffA);
            PG8_BAR; PG8_WAIT_L(0); PG8_MMA(1, 0, At, B0); PG8_BAR; PG8_SCHED;
            PG8_STAGE(PG8_SB(1, 1), b3 + hstep, voffB);
            PG8_WAIT_V(6); PG8_BAR; PG8_MMA(1, 1, At, B1); PG8_BAR;
        }
        PG8_STAMP();
        if constexpr (!Epi::AFTER_DRAIN) { E(acc, cur, wr, wc, fr, fq); S.done(cur); }
        PG8_STAMP();
        if (!has_next) break;
#pragma unroll
        for (int a = 0; a < 2; ++a)
#pragma unroll
            for (int b = 0; b < 2; ++b)
#pragma unroll
                for (int m = 0; m < 4; ++m)
#pragma unroll
                    for (int n = 0; n < 2; ++n) acc[a][b][m][n] = (f32x4){0.f, 0.f, 0.f, 0.f};
        cur = nxt; cA = nA; cB = nB; ++ui;
    }
    PG8_WAIT_V(0);
    if (wr == 0) PG8_BAR;
    PG8_BAR;
    if constexpr (Epi::AFTER_DRAIN) { E.fused(acc, cur, wr, wc, fr, fq, lds, wid, lane); S.done(cur); }
    PG8_STAMP();
    if (STAMP && wid == 0) { stamps[lane] = lane < nts ? (((unsigned long long)(unsigned)ts_hi << 32) | (unsigned)ts_lo) : 0ull;
        if (lane == 62) stamps[62] = rt_entry; if (lane == 63) stamps[63] = (unsigned long long)wall_clock64(); }
#undef PG8_STAMP
#undef PG8_SA
#undef PG8_SB
#undef PG8_STAGE
#undef PG8_LDA
#undef PG8_LDB
#undef PG8_MMA
#undef PG8_WAIT_V
#undef PG8_WAIT_L
#undef PG8_BAR
#undef PG8_SCHED
}
struct Merge3 { const bf16_t* A0; const bf16_t* A1; const bf16_t* A2; const bf16_t* B0; const bf16_t* B1; const bf16_t* B2; int K0, K1, K2; const bf16_t* GL; int ldg; bf16_t* MB; const float* SSY; };
template <class Sched>
__device__ __forceinline__ void gemm_merge3(PG8_LAS unsigned char* lds, const Merge3 g, const Sched& S) {
    constexpr bool STAMP = false; unsigned long long* stamps = nullptr;
    int tid_ = threadIdx.x; asm volatile("" : "+v"(tid_));
    const int tid = tid_, wid = __builtin_amdgcn_readfirstlane(tid >> 6), lane = tid & 63, wr = wid >> 2, wc = wid & 3, fr = lane & 15, fq = lane >> 4;
    int Kc = g.K0, nt = Kc / BK;
    int ts_lo = 0, ts_hi = 0, nts = 0; const unsigned long long rt_entry = STAMP ? (unsigned long long)wall_clock64() : 0ull;
#define PG8_STAMP() do { if (STAMP && wid == 0 && nts < 64) { const unsigned long long _c = (unsigned long long)clock64(); \
        ts_lo = (lane == nts) ? (int)(unsigned)_c : ts_lo; ts_hi = (lane == nts) ? (int)(unsigned)(_c >> 32) : ts_hi; ++nts; } } while (0)
    PG8_STAMP();
    unsigned voffA[2], voffB[2], voffAn[2], voffBn[2]; int Rr[2], Rbr[2], Cc[2];
#pragma unroll
    for (int i = 0; i < 2; ++i) { int R, C; stage_rc(tid * 16 + i * 8192, R, C); Rr[i] = R; Rbr[i] = (R & ~31) + perm32(R & 31); Cc[i] = C;
        voffA[i] = (unsigned)(R * Kc + C) * 2u; voffB[i] = (unsigned)(Rbr[i] * Kc + C) * 2u; voffAn[i] = voffA[i]; voffBn[i] = voffB[i]; }
    const size_t kstep = (size_t)(BK * 2);
    size_t hstep = (size_t)HALF * Kc * 2, hstepn = hstep;
    const unsigned ldsw = (unsigned)wid * 1024u;
    const int aoff = lds_byte(wr * 64 + fr, fq * 8), boff = lds_byte(wc * 32 + fr, fq * 8);
#define PG8_SA(b, h) (((b) * 2 + (h)) * HTB)
#define PG8_SB(b, h) ((4 + (b) * 2 + (h)) * HTB)
#define PG8_STAGE(bufoff, gbase, voff) do { _Pragma("unroll") for (int _i = 0; _i < 2; ++_i) \
        __builtin_amdgcn_global_load_lds((const unsigned*)((const char*)(gbase) + (voff)[_i]), (PG8_LAS unsigned*)(lds + (bufoff) + ldsw + _i * 8192), 16, 0, 0); } while (0)
#define PG8_LDA(dst, b, h) do { _Pragma("unroll") for (int m = 0; m < 4; ++m) _Pragma("unroll") for (int k = 0; k < 2; ++k) dst[m][k] = *(const PG8_LAS bf16x8*)(lds + PG8_SA(b, h) + aoff + m * 2048 + k * 1024); } while (0)
#define PG8_LDB(dst, b, h) do { _Pragma("unroll") for (int n = 0; n < 2; ++n) _Pragma("unroll") for (int k = 0; k < 2; ++k) dst[n][k] = *(const PG8_LAS bf16x8*)(lds + PG8_SB(b, h) + boff + n * 2048 + k * 1024); } while (0)
#define PG8_MMA(ai, bj, At, Bt) do { __builtin_amdgcn_s_setprio(1); _Pragma("unroll") for (int m = 0; m < 4; ++m) _Pragma("unroll") for (int n = 0; n < 2; ++n) _Pragma("unroll") for (int k = 0; k < 2; ++k) \
        acc[ai][bj][m][n] = __builtin_amdgcn_mfma_f32_16x16x32_bf16(Bt[n][k], At[m][k], acc[ai][bj][m][n], 0, 0, 0); __builtin_amdgcn_s_setprio(0); } while (0)
#define PG8_WAIT_V(n) asm volatile("s_waitcnt vmcnt(" #n ")" ::: "memory")
#define PG8_WAIT_L(n) asm volatile("s_waitcnt lgkmcnt(" #n ")" ::: "memory")
#define PG8_BAR __builtin_amdgcn_s_barrier()
#define PG8_SCHED __builtin_amdgcn_sched_barrier(0)
    Unit cur, nxt; int ui = 0, sub = 0;
    if (!S.next(0, cur)) return;
    f32x4 acc[2][2][4][2];
#pragma unroll
    for (int a = 0; a < 2; ++a)
#pragma unroll
        for (int b = 0; b < 2; ++b)
#pragma unroll
            for (int m = 0; m < 4; ++m)
#pragma unroll
                for (int n = 0; n < 2; ++n) acc[a][b][m][n] = (f32x4){0.f, 0.f, 0.f, 0.f};
    bf16x8 At[4][2], B0[2][2], B1[2][2];
    const char* cA = (const char*)g.A0 + (size_t)cur.pm * 2 * hstep; const char* cB = (const char*)g.B0 + (size_t)cur.pn * 2 * hstep;
    S.a_ready(cur);
    PG8_STAGE(PG8_SB(0, 0), cB, voffB); PG8_STAGE(PG8_SA(0, 0), cA, voffA); PG8_STAGE(PG8_SB(0, 1), cB + hstep, voffB); PG8_STAGE(PG8_SA(0, 1), cA + hstep, voffA);
    if (wr == 1) PG8_BAR;
    PG8_WAIT_V(4); PG8_BAR;
    PG8_STAGE(PG8_SB(1, 0), cB + kstep, voffB); PG8_STAGE(PG8_SA(1, 0), cA + kstep, voffA); PG8_STAGE(PG8_SB(1, 1), cB + hstep + kstep, voffB);
    PG8_WAIT_V(6); PG8_BAR;
    PG8_STAMP();
    for (;;) {
        const int subn = (sub == 2) ? 0 : sub + 1; bool has_next = true; nxt = cur;
        if (sub == 2) has_next = S.next(ui + 1, nxt);
        const int Kn = has_next ? ((subn == 0) ? g.K0 : ((subn == 1) ? g.K1 : g.K2)) : Kc;
        hstepn = (size_t)HALF * Kn * 2;
#pragma unroll
        for (int i = 0; i < 2; ++i) { voffAn[i] = (unsigned)(Rr[i] * Kn + Cc[i]) * 2u; voffBn[i] = (unsigned)(Rbr[i] * Kn + Cc[i]) * 2u; }
        const bf16_t* An_ = (subn == 0) ? g.A0 : ((subn == 1) ? g.A1 : g.A2); const bf16_t* Bn_ = (subn == 0) ? g.B0 : ((subn == 1) ? g.B1 : g.B2);
        const char* nA = has_next ? (const char*)An_ + (size_t)nxt.pm * 2 * hstepn : cA; const char* nB = has_next ? (const char*)Bn_ + (size_t)nxt.pn * 2 * hstepn : cB;
        for (int t = 0; t < nt; t += 2) {
            const bool last = (t == nt - 2);
            const char* a1 = cA + (size_t)(t + 1) * kstep;
            const char* a2 = last ? nA : cA + (size_t)(t + 2) * kstep; const char* b2 = last ? nB : cB + (size_t)(t + 2) * kstep;
            const char* a3 = a2 + kstep; const char* b3 = b2 + kstep;
            unsigned vA2[2], vB2[2];
#pragma unroll
            for (int i = 0; i < 2; ++i) { vA2[i] = last ? voffAn[i] : voffA[i]; vB2[i] = last ? voffBn[i] : voffB[i]; }
            const size_t h2 = last ? hstepn : hstep;
            PG8_LDB(B0, 0, 0); PG8_SCHED; PG8_LDA(At, 0, 0); PG8_STAGE(PG8_SA(1, 1), a1 + hstep, voffA);
            PG8_WAIT_L(8); PG8_BAR; PG8_WAIT_L(0); PG8_MMA(0, 0, At, B0); PG8_BAR; PG8_SCHED;
            PG8_LDB(B1, 0, 1); PG8_STAGE(PG8_SB(0, 0), b2, vB2);
            PG8_BAR; PG8_WAIT_L(0); PG8_MMA(0, 1, At, B1); PG8_BAR;
            PG8_LDA(At, 0, 1); PG8_STAGE(PG8_SA(0, 0), a2, vA2);
            PG8_BAR; PG8_WAIT_L(0); PG8_MMA(1, 0, At, B0); PG8_BAR; PG8_SCHED;
            PG8_STAGE(PG8_SB(0, 1), b2 + h2, vB2);
            PG8_WAIT_V(6); PG8_BAR; PG8_MMA(1, 1, At, B1); PG8_BAR;
            PG8_LDB(B0, 1, 0); PG8_SCHED; PG8_LDA(At, 1, 0); PG8_STAGE(PG8_SA(0, 1), a2 + h2, vA2);
            PG8_WAIT_L(8); PG8_BAR; PG8_WAIT_L(0); PG8_MMA(0, 0, At, B0); PG8_BAR; PG8_SCHED;
            PG8_LDB(B1, 1, 1); PG8_STAGE(PG8_SB(1, 0), b3, vB2);
            PG8_BAR; PG8_WAIT_L(0); PG8_MMA(0, 1, At, B1); PG8_BAR;
            PG8_LDA(At, 1, 1); PG8_STAGE(PG8_SA(1, 0), a3, vA2);
            PG8_BAR; PG8_WAIT_L(0); PG8_MMA(1, 0, At, B0); PG8_BAR; PG8_SCHED;
            PG8_STAGE(PG8_SB(1, 1), b3 + h2, vB2);
            PG8_WAIT_V(6); PG8_BAR; PG8_MMA(1, 1, At, B1); PG8_BAR;
        }
        PG8_STAMP();
        {
            const int row0 = cur.pm * BM + wr * 64 + fr, col0 = cur.pn * BM + wc * 32 + 8 * fq;
#pragma unroll
            for (int ai = 0; ai < 2; ++ai)
#pragma unroll
                for (int m = 0; m < 4; ++m) { const size_t row = (size_t)(row0 + ai * HALF + m * 16);
                    const float rs = (sub == 0) ? rsqrtf(g.SSY[row] * (1.f / 2048.f) + 1e-6f) : 1.f;
#pragma unroll
                    for (int bj = 0; bj < 2; ++bj) { const bf16_t* gp = g.GL + row * g.ldg + col0 + bj * HALF;
                        f32x4 v0 = acc[ai][bj][m][0] * rs, v1 = acc[ai][bj][m][1] * rs;
                        if (sub < 2) { const u32x4 ga = *(const u32x4*)(gp + sub * 2048), gb = *(const u32x4*)(gp + (sub + 1) * 2048);
#define PG8_RAT(x, y) ((1.0f + __expf(-(y))) * __builtin_amdgcn_rcpf(1.0f + __expf(-(x))))
                            v0[0] *= PG8_RAT(bflo(ga.x), bflo(gb.x)); v0[1] *= PG8_RAT(bfhi(ga.x), bfhi(gb.x)); v0[2] *= PG8_RAT(bflo(ga.y), bflo(gb.y)); v0[3] *= PG8_RAT(bfhi(ga.y), bfhi(gb.y));
                            v1[0] *= PG8_RAT(bflo(ga.z), bflo(gb.z)); v1[1] *= PG8_RAT(bfhi(ga.z), bfhi(gb.z)); v1[2] *= PG8_RAT(bflo(ga.w), bflo(gb.w)); v1[3] *= PG8_RAT(bfhi(ga.w), bfhi(gb.w));
#undef PG8_RAT
                            acc[ai][bj][m][0] = v0; acc[ai][bj][m][1] = v1;
                        } else { const u32x4 gc = *(const u32x4*)(gp + 4096);
                            u32x4 w; w.x = cvt_pk_bf16(v0[0] * sigmoidf_(bflo(gc.x)), v0[1] * sigmoidf_(bfhi(gc.x))); w.y = cvt_pk_bf16(v0[2] * sigmoidf_(bflo(gc.y)), v0[3] * sigmoidf_(bfhi(gc.y)));
                            w.z = cvt_pk_bf16(v1[0] * sigmoidf_(bflo(gc.z)), v1[1] * sigmoidf_(bfhi(gc.z))); w.w = cvt_pk_bf16(v1[2] * sigmoidf_(bflo(gc.w)), v1[3] * sigmoidf_(bfhi(gc.w)));
                            *(u32x4*)(g.MB + row * 2048 + col0 + bj * HALF) = w;
                            acc[ai][bj][m][0] = (f32x4){0.f, 0.f, 0.f, 0.f}; acc[ai][bj][m][1] = (f32x4){0.f, 0.f, 0.f, 0.f}; } } }
        }
        PG8_STAMP();
        if (!has_next) break;
        if (sub == 2) ++ui;
        cur = nxt; cA = nA; cB = nB; sub = subn; Kc = Kn; nt = Kc / BK; hstep = hstepn;
#pragma unroll
        for (int i = 0; i < 2; ++i) { voffA[i] = voffAn[i]; voffB[i] = voffBn[i]; }
    }
    PG8_WAIT_V(0);
    if (wr == 0) PG8_BAR;
    PG8_BAR;
    PG8_STAMP();
    if (STAMP && wid == 0) { stamps[lane] = lane < nts ? (((unsigned long long)(unsigned)ts_hi << 32) | (unsigned)ts_lo) : 0ull;
        if (lane == 62) stamps[62] = rt_entry; if (lane == 63) stamps[63] = (unsigned long long)wall_clock64(); }
#undef PG8_STAMP
#undef PG8_SA
#undef PG8_SB
#undef PG8_STAGE
#undef PG8_LDA
#undef PG8_LDB
#undef PG8_MMA
#undef PG8_WAIT_V
#undef PG8_WAIT_L
#undef PG8_BAR
#undef PG8_SCHED
}
}

using pg8::bf16_t; using pg8::f32x4; using pg8::u32x4; using pg8::f32x2; using pg8::u32x2;
using pg8::bf2f; using pg8::bflo; using pg8::bfhi; using pg8::sigmoidf_; using pg8::siluf_; using pg8::cvt_pk_bf16;
#define LAS __attribute__((address_space(3)))
constexpr int SEQ = 2048, MTOK = 8192, DM = 2048, NIN = 20512, NP = 20736, PLE = 256, CONVC = 3072;
constexpr int C_ZSSD = 0, C_XBC = 2048, C_UPOOL = 5120, C_ZPOOL = 7168, C_Q = 9216, C_K = 10752, C_V = 12288, C_ZATTN = 13824, C_GATES = 14336, C_DT = 20480;
constexpr float RMS_EPS = 1e-6f;
constexpr size_t MiB = 1u << 20;
constexpr size_t WS_WT_IN = 0, WT_IN_STRIDE = (size_t)NP * DM;
constexpr size_t WS_WT_BRSSD = 162 * MiB, WS_WT_BRPOOL = 178 * MiB, WS_WT_OUT = 194 * MiB, WS_WT_GATE = 210 * MiB;
constexpr size_t WS_WT_BRATTN = 226 * MiB, WS_WT_POOL = 230 * MiB, WS_WT_PROJ = 234 * MiB, WS_PBF = 236 * MiB;
constexpr size_t WS_H = 244 * MiB, WS_PROJ = 276 * MiB, WS_XBC = 600 * MiB, WS_DT = 648 * MiB, WS_DA = 649 * MiB;
constexpr size_t WS_YRAW = 650 * MiB, WS_YSSD = 682 * MiB, WS_POOLED = 714 * MiB, WS_YPOOL = 746 * MiB;
constexpr size_t WS_QN = 778 * MiB, WS_KN = 802 * MiB, WS_VT = 826 * MiB, WS_YATTN = 850 * MiB;
constexpr size_t WS_MF = 858 * MiB, WS_MB = 922 * MiB, WS_H2 = 954 * MiB, WS_PP = 986 * MiB, WS_XT = 1050 * MiB, WS_BT = 1082 * MiB, WS_OG = 1090 * MiB, WS_LSE = 1114 * MiB, WS_SS = 1115 * MiB, WS_BAR = 1116 * MiB, WS_END = 1117 * MiB;
constexpr int LDS_BYTES = 148480;

#ifndef EXP
#define EXP 0
#endif
#define REP(k) for (int rep_ = 0; rep_ < ((EXP == (k)) ? 2 : 1); ++rep_)
struct Params { const float* in[21]; float* out; unsigned char* ws; };
enum { I_X = 0, I_P, I_NORM_G, I_W_IN, I_CONV_W, I_CONV_B, I_DT_BIAS, I_A_LOG, I_D_SKIP, I_SSD_NORM_G, I_W_BR_SSD, I_POOL_W, I_POOL_SCALE, I_W_BR_POOL,
       I_Q_NORM_G, I_K_NORM_G, I_W_BR_ATTN, I_W_OUT, I_PLE_NORM_G, I_W_PLE_GATE, I_W_PLE_PROJ };

__device__ __forceinline__ float wave_sum(float v) {
#pragma unroll
    for (int o = 1; o < 64; o <<= 1) v += __shfl_xor(v, o);
    return v;
}
#define LDS_WAIT() asm volatile("s_waitcnt lgkmcnt(0)" ::: "memory")

#define XB_TMO      128
#define XB_XCNT(j)  (256  + 64 * (j))
#define XB_XSUB(j)  (1280 + 64 * (j))
#define XB_XGEN(j)  (2304 + 64 * (j))
#define XB_TOP      3328
#define XB_TOPGEN   3392
#define XCD_BAR_WORDS 3456
#define XB_SPIN_CAP (1u << 18)

__device__ __forceinline__ unsigned xb_ld(unsigned* p)              { return __hip_atomic_load(p, __ATOMIC_RELAXED, __HIP_MEMORY_SCOPE_AGENT); }
__device__ __forceinline__ unsigned xb_add(unsigned* p, unsigned v) { return __hip_atomic_fetch_add(p, v, __ATOMIC_RELAXED, __HIP_MEMORY_SCOPE_AGENT); }
__device__ __forceinline__ unsigned xb_xcc_id() { return (unsigned)__builtin_amdgcn_s_getreg((3 << 11) | 20) & 0xFu; }
#define XB_SPIN(cond, bar) do { unsigned _sp = 0; while (cond) { __builtin_amdgcn_s_sleep(1); \
    if ((++_sp & 255u) == 0u) { if (xb_ld(&(bar)[XB_TMO])) break; if (_sp > XB_SPIN_CAP) { atomicAdd(&(bar)[XB_TMO], 1u); break; } } } } while (0)

struct XcdBarrier {
    unsigned* bar; unsigned x;
    volatile LAS unsigned* st;
};

__device__ __forceinline__ XcdBarrier xcd_barrier_post(unsigned* bar, volatile LAS unsigned* st) {
    XcdBarrier b; b.bar = bar; b.x = xb_xcc_id(); b.st = st;
    if (threadIdx.x == 0) (void)xb_add(&bar[XB_XCNT(b.x)], 1u);
    return b;
}
__device__ __forceinline__ void xcd_barrier_complete(unsigned* bar, unsigned x, unsigned& nloc, unsigned& nx) {
    const unsigned G = gridDim.x * gridDim.y * gridDim.z;
    unsigned sum, cnt, mine, sp = 0u;
    for (;;) {
        sum = 0u; cnt = 0u; mine = 0u;
#pragma unroll
        for (unsigned j = 0; j < 16; ++j) { const unsigned c = xb_ld(&bar[XB_XCNT(j)]); sum += c; cnt += (c > 0u) ? 1u : 0u; mine = (j == x) ? c : mine; }
        if (sum == G) break;
        __builtin_amdgcn_s_sleep(1);
        if ((++sp & 255u) == 0u) { if (xb_ld(&bar[XB_TMO])) break; if (sp > XB_SPIN_CAP) { atomicAdd(&bar[XB_TMO], 1u); break; } }
    }
    nloc = mine > 0u ? mine : 1u; nx = cnt > 0u ? cnt : 1u;
}

__device__ __forceinline__ void xcd_barrier(const XcdBarrier& b) {
    asm volatile("s_waitcnt vmcnt(0)" ::: "memory");
    __syncthreads();
    if (threadIdx.x == 0) {
        unsigned* bar = b.bar;
        __builtin_amdgcn_s_waitcnt(0);
        unsigned nloc = b.st[0], nx = b.st[1];
        if (nloc == 0u) { xcd_barrier_complete(bar, b.x, nloc, nx); b.st[0] = nloc; b.st[1] = nx; }
        const unsigned old = xb_add(&bar[XB_XSUB(b.x)], 1u);
        const unsigned gen = old / nloc;
        if (old + 1u == (gen + 1u) * nloc) {
            __builtin_amdgcn_fence(__ATOMIC_RELEASE, "agent");
            asm volatile("s_waitcnt vmcnt(0)" ::: "memory");
            const unsigned og = xb_add(&bar[XB_TOP], 1u);
            const unsigned tg = og / nx;
            if (og + 1u == (tg + 1u) * nx) xb_add(&bar[XB_TOPGEN], 1u);
            else XB_SPIN(xb_ld(&bar[XB_TOPGEN]) == tg, bar);
            __builtin_amdgcn_fence(__ATOMIC_ACQUIRE, "agent");
            xb_add(&bar[XB_XGEN(b.x)], 1u);
            asm volatile("s_waitcnt vmcnt(0)" ::: "memory");
        } else {
            XB_SPIN(xb_ld(&bar[XB_XGEN(b.x)]) == gen, bar);
            __builtin_amdgcn_fence(__ATOMIC_ACQUIRE, "agent");
            asm volatile("s_waitcnt vmcnt(0)" ::: "memory");
        }
    }
    __syncthreads();
}


__device__ __forceinline__ void transpose_item(const float* W, int K, int N, bf16_t* WT, int remap, LAS float* scr, int item, int lane, const float* gk = nullptr) {
    LAS bf16_t* T = (LAS bf16_t*)scr;
    const int nblk = N / 32, kb = item / nblk, nb = item % nblk, k0 = 128 * kb, n0 = 32 * nb;
    const int ksub = lane >> 3, n4 = (lane & 7) * 4;
    f32x4 v[16];
#pragma unroll
    for (int i = 0; i < 16; ++i) v[i] = *(const f32x4*)(W + (size_t)(k0 + i * 8 + ksub) * N + n0 + n4);
    if (gk) {
#pragma unroll
        for (int i = 0; i < 16; ++i) v[i] *= gk[k0 + i * 8 + ksub]; }
#pragma unroll
    for (int i = 0; i < 16; ++i) { const int k = i * 8 + ksub; const unsigned p01 = cvt_pk_bf16(v[i][0], v[i][1]), p23 = cvt_pk_bf16(v[i][2], v[i][3]);
        T[(n4 + 0) * 136 + k] = (bf16_t)(p01 & 0xffffu); T[(n4 + 1) * 136 + k] = (bf16_t)(p01 >> 16); T[(n4 + 2) * 136 + k] = (bf16_t)(p23 & 0xffffu); T[(n4 + 3) * 136 + k] = (bf16_t)(p23 >> 16); }
    LDS_WAIT(); asm volatile("" ::: "memory");
    int d0 = n0;
    if (remap) d0 = (n0 < 5120) ? n0 : ((n0 < 5152) ? (C_DT + (n0 - 5120)) : (n0 - 32));
    const int nsub = lane >> 4, kc = (lane & 15) * 8;
#pragma unroll
    for (int j = 0; j < 8; ++j) { const int n = j * 4 + nsub;
        *(u32x4*)(WT + (size_t)(d0 + n) * K + k0 + kc) = *(const LAS u32x4*)(T + n * 136 + kc); }
    LDS_WAIT(); asm volatile("" ::: "memory");
}

__device__ __forceinline__ void row_to_bf16_ss(const float* xrow, bf16_t* orow, float* ssp, int lane) {
    float s = 0.f;
#pragma unroll
    for (int j = 0; j < 8; ++j) { const f32x4 v = *(const f32x4*)(xrow + 256 * j + 4 * lane); s += (v[0] * v[0] + v[1] * v[1]) + (v[2] * v[2] + v[3] * v[3]);
        u32x2 w; w.x = cvt_pk_bf16(v[0], v[1]); w.y = cvt_pk_bf16(v[2], v[3]); *(u32x2*)(orow + 256 * j + 4 * lane) = w; }
    s = wave_sum(s);
    if (lane == 0) *ssp = s;
}
__device__ __forceinline__ void rms_row_to_bf16(const float* xrow, const float* g, bf16_t* orow, int lane) {
    f32x4 v[8]; float s = 0.f;
#pragma unroll
    for (int j = 0; j < 8; ++j) { v[j] = *(const f32x4*)(xrow + 256 * j + 4 * lane); s += (v[j][0] * v[j][0] + v[j][1] * v[j][1]) + (v[j][2] * v[j][2] + v[j][3] * v[j][3]); }
    const float rinv = rsqrtf(wave_sum(s) * (1.f / 2048.f) + RMS_EPS);
#pragma unroll
    for (int j = 0; j < 8; ++j) { const f32x4 gg = *(const f32x4*)(g + 256 * j + 4 * lane);
        u32x2 w; w.x = cvt_pk_bf16(v[j][0] * rinv * gg[0], v[j][1] * rinv * gg[1]); w.y = cvt_pk_bf16(v[j][2] * rinv * gg[2], v[j][3] * rinv * gg[3]);
        *(u32x2*)(orow + 256 * j + 4 * lane) = w; }
}


typedef short bf16x8 __attribute__((ext_vector_type(8)));
typedef short bf16x4 __attribute__((ext_vector_type(4)));
typedef float f32x16 __attribute__((ext_vector_type(16)));
typedef __bf16 bf16v2 __attribute__((ext_vector_type(2)));
#define MFMA32(a, b, c) __builtin_amdgcn_mfma_f32_32x32x16_bf16((a), (b), (c), 0, 0, 0)
__device__ __forceinline__ unsigned pkbf(float lo, float hi) { f32x2 v = {lo, hi}; return __builtin_bit_cast(unsigned, __builtin_convertvector(v, bf16v2)); }
__device__ __forceinline__ bf16x8 pack8(float a, float b, float c, float d, float e, float f, float g, float h) {
    u32x4 w = {pkbf(a, b), pkbf(c, d), pkbf(e, f), pkbf(g, h)}; return __builtin_bit_cast(bf16x8, w); }

__device__ __forceinline__ void wave_tile_transpose_store(const LAS bf16_t* tile, bf16_t* dst, int lane) {
#pragma unroll
    for (int half = 0; half < 2; ++half) { const int cc = lane + 64 * half;
        unsigned w[16];
#pragma unroll
        for (int i = 0; i < 16; ++i) w[i] = (unsigned)tile[(2 * i) * 136 + cc] | ((unsigned)tile[(2 * i + 1) * 136 + cc] << 16);
        bf16_t* d = dst + (size_t)cc * SEQ;
#pragma unroll
        for (int q = 0; q < 4; ++q) *(u32x4*)(d + 8 * q) = (u32x4){w[4 * q], w[4 * q + 1], w[4 * q + 2], w[4 * q + 3]}; }
}

template <int KS> __device__ __forceinline__ void wave_tile_transpose_store_frag(const LAS bf16_t* tile, bf16_t* dst, int rt0, int half32, int lane) {
#pragma unroll
    for (int half = 0; half < 2; ++half) { const int cc = lane + 64 * half;
        unsigned w[16];
#pragma unroll
        for (int i = 0; i < 16; ++i) w[i] = (unsigned)tile[(2 * i) * 136 + cc] | ((unsigned)tile[(2 * i + 1) * 136 + cc] << 16);
        const int rt = rt0 + (cc >> 5);
#pragma unroll
        for (int q = 0; q < 4; ++q) { const int ks = half32 * 2 + (q >> 1), hh = q & 1;
            *(u32x4*)(dst + ((size_t)(rt * KS + ks)) * 512 + (hh * 32 + (cc & 31)) * 8) = (u32x4){w[4 * q], w[4 * q + 1], w[4 * q + 2], w[4 * q + 3]}; } }
}

__device__ __forceinline__ void attn_item(const bf16_t* QNp, const bf16_t* KNp, const bf16_t* VTp, bf16_t* OGp, float* LSEp, int item, int lane) {
    const int g = item >> 10; int rem = item & 1023;
    const int b = rem >> 8; rem &= 255; const int j = rem >> 6; rem &= 63;
    const int sh = 2 * g, dil = 1 << sh, ld = SEQ >> sh;
    const int pos0 = rem * 32, r = pos0 >> (11 - sh), s0 = pos0 & (ld - 1), head = g * 4 + j;
    const int qc = lane & 31, hh = lane >> 5;
    const size_t mq = (size_t)b * SEQ + (size_t)(s0 + qc) * dil + r;
    bf16x8 qf[8];
#pragma unroll
    for (int ks = 0; ks < 8; ++ks) qf[ks] = *(const bf16x8*)(QNp + ((size_t)(((b * 12 + head) * 64 + rem) * 8 + ks)) * 512 + lane * 8);
    f32x16 o[4];
#pragma unroll
    for (int d = 0; d < 4; ++d)
#pragma unroll
        for (int i = 0; i < 16; ++i) o[d][i] = 0.f;
    float mrun = -INFINITY, lh = 0.f;
    const bf16_t* kfb = KNp + ((size_t)((b * 12 + head) * 64 + rem - 4) * 8) * 512 + lane * 8;
    const bf16_t* vtb = VTp + ((size_t)((b * 12 + head) * 64 + rem - 4) * 8) * 512 + qc * 8 + 4 * hh;
    const float sc = 0.08838834764831845f * 1.4426950408889634f;
    const int kt0 = (s0 >= 128) ? 0 : (4 - (s0 >> 5));
    bf16x8 kf[8];
#pragma unroll
    for (int ks = 0; ks < 8; ++ks) kf[ks] = *(const bf16x8*)(kfb + kt0 * 4096 + ks * 512);
#pragma unroll 1
    for (int kt = kt0; kt < 5; ++kt) {
        bf16x4 vlo[8], vhi[8];
#pragma unroll
        for (int q = 0; q < 8; ++q) { const bf16_t* vp = vtb + kt * 4096 + q * 512; vlo[q] = *(const bf16x4*)vp; vhi[q] = *(const bf16x4*)(vp + 256); }
        const int ktn = (kt < 4) ? kt + 1 : kt;
        bf16x8 kn[8];
#pragma unroll
        for (int ks = 0; ks < 8; ++ks) kn[ks] = *(const bf16x8*)(kfb + ktn * 4096 + ks * 512);
        f32x16 sa, sb;
#pragma unroll
        for (int i = 0; i < 16; ++i) { sa[i] = 0.f; sb[i] = 0.f; }
#pragma unroll
        for (int ks = 0; ks < 8; ks += 2) { sa = MFMA32(kf[ks], qf[ks], sa); sb = MFMA32(kf[ks + 1], qf[ks + 1], sb); }
        float tmax = -INFINITY;
#pragma unroll
        for (int i = 0; i < 16; ++i) { const int kr = (i & 3) + 8 * (i >> 2) + 4 * hh;
            const bool ok = (kt == 0) ? (kr >= qc) : ((kt == 4) ? (kr <= qc) : true);
            const float v = ok ? (sa[i] + sb[i]) * sc : -INFINITY; sa[i] = v; tmax = fmaxf(tmax, v); }
        tmax = fmaxf(tmax, __shfl_xor(tmax, 32));
        const float mnew = fmaxf(mrun, tmax), alpha = __builtin_amdgcn_exp2f(mrun - mnew); mrun = mnew;
        float psum = 0.f;
#pragma unroll
        for (int i = 0; i < 16; ++i) { const float p = __builtin_amdgcn_exp2f(sa[i] - mnew); sa[i] = p; psum += p; }
        lh = lh * alpha + psum;
#pragma unroll
        for (int d = 0; d < 4; ++d)
#pragma unroll
            for (int i = 0; i < 16; ++i) o[d][i] *= alpha;
#pragma unroll
        for (int ks2 = 0; ks2 < 2; ++ks2) {
            const bf16x8 pf = pack8(sa[8 * ks2 + 0], sa[8 * ks2 + 1], sa[8 * ks2 + 2], sa[8 * ks2 + 3], sa[8 * ks2 + 4], sa[8 * ks2 + 5], sa[8 * ks2 + 6], sa[8 * ks2 + 7]);
#pragma unroll
            for (int d = 0; d < 4; ++d) {
                const bf16x8 vf = __builtin_shufflevector(vlo[d * 2 + ks2], vhi[d * 2 + ks2], 0, 1, 2, 3, 4, 5, 6, 7);
                o[d] = MFMA32(vf, pf, o[d]); }
        }
#pragma unroll
        for (int ks = 0; ks < 8; ++ks) kf[ks] = kn[ks];
    }
    const float l = lh + __shfl_xor(lh, 32), il = 1.f / l;
    bf16_t* op = OGp + ((size_t)g * MTOK + mq) * 512 + j * 128;
#pragma unroll
    for (int d = 0; d < 4; ++d)
#pragma unroll
        for (int i4 = 0; i4 < 4; ++i4) { u32x2 w; w.x = pkbf(o[d][4 * i4] * il, o[d][4 * i4 + 1] * il); w.y = pkbf(o[d][4 * i4 + 2] * il, o[d][4 * i4 + 3] * il);
            *(u32x2*)(op + d * 32 + 8 * i4 + 4 * hh) = w; }
    if (hh == 0) LSEp[((size_t)g * MTOK + mq) * 4 + j] = mrun * 0.6931471805599453f + __logf(l);
}

__device__ __forceinline__ void ssd_block(LAS unsigned char* lds, const bf16_t* CFp, const bf16_t* BFp, const bf16_t* XTp, const bf16_t* BTp, const float* DTp, const float* DAp, bf16_t* YRAWp, const bf16_t* Zp, float* SSYp, float Dh, int b, int h, int tid) {
    const int lane = tid & 63, wave = __builtin_amdgcn_readfirstlane(tid >> 6), qc = lane & 31, hh = lane >> 5, g = h >> 3;
    LAS bf16_t* Sb0 = (LAS bf16_t*)lds; LAS bf16_t* Sb1 = (LAS bf16_t*)(lds + 17408);
    LAS float* cumL = (LAS float*)(lds + 36864 + wave * 1024); LAS float* dtL = cumL + 64; LAS float* wL = cumL + 128;
    for (int i = tid; i < 17408 / 4; i += 512) ((LAS unsigned*)Sb0)[i] = 0u;
    const int pt = wave & 1, lt = (wave >> 1) & 1, l = lt * 32 + qc, nt0 = 2 * lt;
    const bool ywave = wave < 4;
    const bf16_t* cfb = CFp + ((size_t)(b * 32) * 4 + g) * 8192 + lt * 4096 + lane * 8;
    const bf16_t* bfb = BFp + ((size_t)(b * 32) * 4 + g) * 8192 + lane * 8;
    const bf16_t* xtb = XTp + ((size_t)(b * 32) * 64 + h * 2 + pt) * 2048;
    const bf16_t* btb = BTp + ((size_t)(b * 32) * 16 + g * 4 + nt0) * 2048 + lane * 8;
    LAS unsigned char* FB = lds + 49152;
    const bf16_t* cfc = CFp + ((size_t)(b * 32) * 4 + g) * 8192 + lane * 8;
    const bf16_t* bfc = BFp + ((size_t)(b * 32) * 4 + g) * 8192 + lane * 8;
    const bf16_t* btc = BTp + ((size_t)(b * 32) * 4 + g) * 8192 + lane * 8;
#define SSD_DMA(cc, bi) do { _Pragma("unroll") for (int q_ = 0; q_ < 6; ++q_) { const int j_ = wave * 6 + q_; \
        const bf16_t* src_ = ((j_ < 16) ? cfc : ((j_ < 32) ? bfc : btc)) + (size_t)(cc) * 32768 + (j_ & 15) * 512; \
        __builtin_amdgcn_global_load_lds((const unsigned*)src_, (LAS unsigned*)(FB + (bi) * 49152 + j_ * 1024), 16, 0, 0); } } while (0)
    SSD_DMA(0, 0); SSD_DMA(1, 1);
    asm volatile("s_waitcnt vmcnt(0)" ::: "memory");
    __syncthreads();
    if (ywave) {
        bf16x8 cf[8], bf0[8], bf1[8]; bf16x4 xk[4][2];
        float dav = DAp[(((size_t)b * 32) * 32 + h) * 64 + lane], dtv = DTp[(((size_t)b * 32) * 32 + h) * 64 + lane];
#pragma unroll
        for (int q = 0; q < 4; ++q) { xk[q][0] = *(const bf16x4*)(xtb + q * 512 + qc * 8 + 4 * hh); xk[q][1] = *(const bf16x4*)(xtb + q * 512 + (32 + qc) * 8 + 4 * hh); }
#pragma unroll 1
        for (int c = 0; c < 32; ++c) {
            const int t0 = c * 64, cn = (c < 31) ? c + 1 : c; const size_t m0 = (size_t)b * SEQ + t0;
            LAS bf16_t* Scur = (c & 1) ? Sb1 : Sb0;
            { const LAS unsigned char* fb = FB + (c & 1) * 49152 + lane * 16;
#pragma unroll
              for (int ks = 0; ks < 8; ++ks) { cf[ks] = *(const LAS bf16x8*)(fb + (lt * 8 + ks) * 1024); bf0[ks] = *(const LAS bf16x8*)(fb + 16384 + ks * 1024); bf1[ks] = *(const LAS bf16x8*)(fb + 24576 + ks * 1024); } }
            u32x2 zz[4];
#pragma unroll
            for (int i4 = 0; i4 < 4; ++i4) zz[i4] = *(const u32x2*)(Zp + (m0 + l) * NP + h * 64 + pt * 32 + 8 * i4 + 4 * hh);
            cumL[lane] = dav; dtL[lane] = dtv;
            LDS_WAIT(); asm volatile("" ::: "memory");
            f32x16 y, cb0, cb1;
#pragma unroll
            for (int i = 0; i < 16; ++i) { y[i] = 0.f; cb0[i] = 0.f; cb1[i] = 0.f; }
            if (lt == 1) {
#pragma unroll
                for (int ks = 0; ks < 8; ++ks) { const bf16x8 sf = *(const LAS bf16x8*)(Scur + (pt * 32 + qc) * 136 + ks * 16 + hh * 8);
                    y = MFMA32(sf, cf[ks], y); cb0 = MFMA32(bf0[ks], cf[ks], cb0); cb1 = MFMA32(bf1[ks], cf[ks], cb1); }
            } else {
#pragma unroll
                for (int ks = 0; ks < 8; ++ks) { const bf16x8 sf = *(const LAS bf16x8*)(Scur + (pt * 32 + qc) * 136 + ks * 16 + hh * 8);
                    y = MFMA32(sf, cf[ks], y); cb0 = MFMA32(bf0[ks], cf[ks], cb0); }
            }
            dav = DAp[(((size_t)b * 32 + cn) * 32 + h) * 64 + lane]; dtv = DTp[(((size_t)b * 32 + cn) * 32 + h) * 64 + lane];
            const float cuml = cumL[l], el = __builtin_amdgcn_exp2f(cuml);
#pragma unroll
            for (int i = 0; i < 16; ++i) y[i] *= el;
#pragma unroll
            for (int st = 0; st < 2; ++st) if (st <= lt) {
                f32x16 cb = (st == 0) ? cb0 : cb1;
#pragma unroll
                for (int i4 = 0; i4 < 4; ++i4) { const int sb = st * 32 + 8 * i4 + 4 * hh;
                    const f32x4 cs = *(const LAS f32x4*)(cumL + sb), ds = *(const LAS f32x4*)(dtL + sb);
#pragma unroll
                    for (int e = 0; e < 4; ++e) { const float v = cb[4 * i4 + e] * __builtin_amdgcn_exp2f(cuml - cs[e]) * ds[e]; cb[4 * i4 + e] = (st < lt) ? v : ((sb + e < l) ? v : ((sb + e == l) ? v + Dh : 0.f)); } }
#pragma unroll
                for (int ks2 = 0; ks2 < 2; ++ks2) {
                    const bf16x8 pf = pack8(cb[8 * ks2 + 0], cb[8 * ks2 + 1], cb[8 * ks2 + 2], cb[8 * ks2 + 3], cb[8 * ks2 + 4], cb[8 * ks2 + 5], cb[8 * ks2 + 6], cb[8 * ks2 + 7]);
                    const bf16x8 xa = __builtin_shufflevector(xk[2 * st + ks2][0], xk[2 * st + ks2][1], 0, 1, 2, 3, 4, 5, 6, 7);
                    y = MFMA32(xa, pf, y); }
            }
#pragma unroll
            for (int q = 0; q < 4; ++q) { xk[q][0] = *(const bf16x4*)(xtb + (size_t)cn * 131072 + q * 512 + qc * 8 + 4 * hh); xk[q][1] = *(const bf16x4*)(xtb + (size_t)cn * 131072 + q * 512 + (32 + qc) * 8 + 4 * hh); }
            float ssy = 0.f;
#pragma unroll
            for (int i4 = 0; i4 < 4; ++i4) { const int p0 = pt * 32 + 8 * i4 + 4 * hh;
                u32x2 w; w.x = pkbf(y[4 * i4] * siluf_(bflo(zz[i4].x)), y[4 * i4 + 1] * siluf_(bfhi(zz[i4].x))); w.y = pkbf(y[4 * i4 + 2] * siluf_(bflo(zz[i4].y)), y[4 * i4 + 3] * siluf_(bfhi(zz[i4].y)));
                *(u32x2*)(YRAWp + (m0 + l) * DM + h * 64 + p0) = w;
                const float r0 = bflo(w.x), r1 = bfhi(w.x), r2 = bflo(w.y), r3 = bfhi(w.y); ssy += (r0 * r0 + r1 * r1) + (r2 * r2 + r3 * r3); }
            ssy += __shfl_xor(ssy, 32);
            if (hh == 0) unsafeAtomicAdd(SSYp + m0 + l, ssy);
            asm volatile("s_waitcnt vmcnt(0)" ::: "memory");
            __syncthreads();
            if (c + 2 < 32) SSD_DMA(c + 2, c & 1);
        }
    } else {
        f32x16 sacc0, sacc1;
#pragma unroll
        for (int i = 0; i < 16; ++i) { sacc0[i] = 0.f; sacc1[i] = 0.f; }
        bf16x8 af0[4], af1[4]; u32x4 xr[4];
        float dav = DAp[(((size_t)b * 32) * 32 + h) * 64 + lane], dtv = DTp[(((size_t)b * 32) * 32 + h) * 64 + lane];
#pragma unroll
        for (int ks = 0; ks < 4; ++ks) xr[ks] = *(const u32x4*)(xtb + ks * 512 + lane * 8);
#pragma unroll 1
        for (int c = 0; c < 32; ++c) {
            const int cn = (c < 31) ? c + 1 : c;
            LAS bf16_t* Snxt = (c & 1) ? Sb0 : Sb1;
            { const LAS unsigned char* fb = FB + (c & 1) * 49152 + 32768 + lane * 16;
#pragma unroll
              for (int ks = 0; ks < 4; ++ks) { af0[ks] = *(const LAS bf16x8*)(fb + (nt0 * 4 + ks) * 1024); af1[ks] = *(const LAS bf16x8*)(fb + (nt0 * 4 + 4 + ks) * 1024); } }
            const float cum = dav, cl = __shfl(cum, 63);
            wL[lane] = dtv * __builtin_amdgcn_exp2f(cl - cum);
            LDS_WAIT(); asm volatile("" ::: "memory");
            const float ecl = __builtin_amdgcn_exp2f(cl);
#pragma unroll
            for (int i = 0; i < 16; ++i) { sacc0[i] *= ecl; sacc1[i] *= ecl; }
#pragma unroll
            for (int ks = 0; ks < 4; ++ks) {
                const f32x4 w0 = *(const LAS f32x4*)(wL + ks * 16 + hh * 8), w1 = *(const LAS f32x4*)(wL + ks * 16 + hh * 8 + 4);
                const bf16x8 xw = pack8(bflo(xr[ks].x) * w0[0], bfhi(xr[ks].x) * w0[1], bflo(xr[ks].y) * w0[2], bfhi(xr[ks].y) * w0[3], bflo(xr[ks].z) * w1[0], bfhi(xr[ks].z) * w1[1], bflo(xr[ks].w) * w1[2], bfhi(xr[ks].w) * w1[3]);
                sacc0 = MFMA32(af0[ks], xw, sacc0); sacc1 = MFMA32(af1[ks], xw, sacc1); }
            dav = DAp[(((size_t)b * 32 + cn) * 32 + h) * 64 + lane]; dtv = DTp[(((size_t)b * 32 + cn) * 32 + h) * 64 + lane];
#pragma unroll
            for (int ks = 0; ks < 4; ++ks) xr[ks] = *(const u32x4*)(xtb + (size_t)cn * 131072 + ks * 512 + lane * 8);
#pragma unroll
            for (int i4 = 0; i4 < 4; ++i4) { u32x2 w; w.x = pkbf(sacc0[4 * i4], sacc0[4 * i4 + 1]); w.y = pkbf(sacc0[4 * i4 + 2], sacc0[4 * i4 + 3]);
                *(LAS u32x2*)(Snxt + (pt * 32 + qc) * 136 + nt0 * 32 + 8 * i4 + 4 * hh) = w;
                u32x2 v; v.x = pkbf(sacc1[4 * i4], sacc1[4 * i4 + 1]); v.y = pkbf(sacc1[4 * i4 + 2], sacc1[4 * i4 + 3]);
                *(LAS u32x2*)(Snxt + (pt * 32 + qc) * 136 + nt0 * 32 + 32 + 8 * i4 + 4 * hh) = v; }
            asm volatile("s_waitcnt vmcnt(0)" ::: "memory");
            __syncthreads();
            if (c + 2 < 32) SSD_DMA(c + 2, c & 1);
        }
    }
}
#undef SSD_DMA

#define WT_IN ((bf16_t*)(ws + WS_WT_IN))
#define WT_BRSSD ((bf16_t*)(ws + WS_WT_BRSSD))
#define WT_BRPOOL ((bf16_t*)(ws + WS_WT_BRPOOL))
#define WT_OUT ((bf16_t*)(ws + WS_WT_OUT))
#define WT_GATE ((bf16_t*)(ws + WS_WT_GATE))
#define WT_BRATTN ((bf16_t*)(ws + WS_WT_BRATTN))
#define WT_POOL ((bf16_t*)(ws + WS_WT_POOL))
#define WT_PROJ ((bf16_t*)(ws + WS_WT_PROJ))
#define PBF ((bf16_t*)(ws + WS_PBF))
#define H ((bf16_t*)(ws + WS_H))
#define PROJ ((bf16_t*)(ws + WS_PROJ))
#define CF ((bf16_t*)(ws + WS_XBC))
#define BF ((bf16_t*)(ws + WS_XBC + 8 * MiB))
#define DTP ((float*)(ws + WS_XBC + 16 * MiB))
#define DT ((float*)(ws + WS_DT))
#define DA ((float*)(ws + WS_DA))
#define YRAW ((bf16_t*)(ws + WS_YRAW))
#define YSSD ((bf16_t*)(ws + WS_YSSD))
#define POOLED ((bf16_t*)(ws + WS_POOLED))
#define YPOOL ((bf16_t*)(ws + WS_YPOOL))
#define QN ((bf16_t*)(ws + WS_QN))
#define KN ((bf16_t*)(ws + WS_KN))
#define YATTN ((bf16_t*)(ws + WS_YATTN))
#define MF ((float*)(ws + WS_MF))
#define MB ((bf16_t*)(ws + WS_MB))
#define H2 ((bf16_t*)(ws + WS_H2))
#define PP ((float*)(ws + WS_PP))
#define VT ((bf16_t*)(ws + WS_VT))
#define XT ((bf16_t*)(ws + WS_XT))
#define BT ((bf16_t*)(ws + WS_BT))
#define OG ((bf16_t*)(ws + WS_OG))
#define LSE ((float*)(ws + WS_LSE))
#define SSQ ((float*)(ws + WS_SS))

constexpr int I_IN = 16 * 641, I_SQ = 16 * 64, I_BA = 4 * 64, I_PW = 4 * 16, I_PP = 2 * 64;
constexpr int I_LAYER = I_IN + 4 * I_SQ + I_BA + 4 * I_PW + I_PP;
__device__ __forceinline__ void convert_weight_item(const Params& P, unsigned char* ws, int L, int r, LAS float* scr, int lane) {
    if (r < I_IN) { transpose_item(P.in[I_W_IN] + (size_t)L * DM * NIN, DM, NIN, WT_IN + (size_t)L * WT_IN_STRIDE, 1, scr, r, lane, P.in[I_NORM_G] + L * DM); return; } r -= I_IN;
    if (r < I_SQ) { transpose_item(P.in[I_W_BR_SSD] + (size_t)L * DM * DM, DM, DM, WT_BRSSD + (size_t)L * DM * DM, 0, scr, r, lane, P.in[I_SSD_NORM_G] + L * DM); return; } r -= I_SQ;
    if (r < I_SQ) { transpose_item(P.in[I_W_BR_POOL] + (size_t)L * DM * DM, DM, DM, WT_BRPOOL + (size_t)L * DM * DM, 0, scr, r, lane); return; } r -= I_SQ;
    if (r < I_SQ) { transpose_item(P.in[I_W_OUT] + (size_t)L * DM * DM, DM, DM, WT_OUT + (size_t)L * DM * DM, 0, scr, r, lane); return; } r -= I_SQ;
    if (r < I_SQ) { transpose_item(P.in[I_W_PLE_GATE] + (size_t)L * DM * DM, DM, DM, WT_GATE + (size_t)L * DM * DM, 0, scr, r, lane, P.in[I_PLE_NORM_G] + L * DM); return; } r -= I_SQ;
    if (r < I_BA) { transpose_item(P.in[I_W_BR_ATTN] + (size_t)L * 512 * DM, 512, DM, WT_BRATTN + (size_t)L * 512 * DM, 0, scr, r, lane); return; } r -= I_BA;
    if (r < 4 * I_PW) { const int g = r / I_PW; transpose_item(P.in[I_POOL_W] + (size_t)(L * 4 + g) * 512 * 512, 512, 512, WT_POOL + (size_t)(L * 4 + g) * 512 * 512, 0, scr, r - g * I_PW, lane); return; } r -= 4 * I_PW;
    transpose_item(P.in[I_W_PLE_PROJ] + (size_t)L * PLE * DM, PLE, DM, WT_PROJ + (size_t)L * PLE * DM, 0, scr, r, lane);
}

template <int W> __device__ __forceinline__ void pooled_run(const bf16_t* up, bf16_t* outp, int m0, int t0) {
    u32x4 xr[15 + W];
#pragma unroll
    for (int q = 0; q < 15 + W; ++q) { const int dt_ = q - (W - 1);
        xr[q] = (t0 + dt_ >= 0) ? *(const u32x4*)(up + (size_t)(m0 + dt_) * NP) : (u32x4){0u, 0u, 0u, 0u}; }
    float s[8];
#pragma unroll
    for (int e = 0; e < 8; ++e) s[e] = 0.f;
#pragma unroll
    for (int q = 0; q < W - 1; ++q) { const u32x4 x = xr[q];
        s[0] += bflo(x.x); s[1] += bfhi(x.x); s[2] += bflo(x.y); s[3] += bfhi(x.y); s[4] += bflo(x.z); s[5] += bfhi(x.z); s[6] += bflo(x.w); s[7] += bfhi(x.w); }
#pragma unroll
    for (int i = 0; i < 16; ++i) { const u32x4 x = xr[i + W - 1]; const int t = t0 + i;
        s[0] += bflo(x.x); s[1] += bfhi(x.x); s[2] += bflo(x.y); s[3] += bfhi(x.y); s[4] += bflo(x.z); s[5] += bfhi(x.z); s[6] += bflo(x.w); s[7] += bfhi(x.w);
        const int cnt = (t + 1 < W) ? (t + 1) : W; const float ic = 1.f / (float)cnt;
        u32x4 o; o.x = cvt_pk_bf16(s[0] * ic - bflo(x.x), s[1] * ic - bfhi(x.x)); o.y = cvt_pk_bf16(s[2] * ic - bflo(x.y), s[3] * ic - bfhi(x.y));
        o.z = cvt_pk_bf16(s[4] * ic - bflo(x.z), s[5] * ic - bfhi(x.z)); o.w = cvt_pk_bf16(s[6] * ic - bflo(x.w), s[7] * ic - bfhi(x.w));
        *(u32x4*)(outp + (size_t)i * 512) = o;
        const u32x4 y = xr[i];
        s[0] -= bflo(y.x); s[1] -= bfhi(y.x); s[2] -= bflo(y.y); s[3] -= bfhi(y.y); s[4] -= bflo(y.z); s[5] -= bfhi(y.z); s[6] -= bflo(y.w); s[7] -= bfhi(y.w); }
}

__device__ __forceinline__ void dt_partial_item(const bf16_t* Hp, const bf16_t* Wdt, float* DTPp, int item, int lane) {
    const int mt = item >> 3, kq = item & 7, qc = lane & 31, hh = lane >> 5;
    const bf16_t* ap = Hp + (size_t)(mt * 32 + qc) * DM + kq * 256 + hh * 8;
    const bf16_t* bp = Wdt + (size_t)qc * DM + kq * 256 + hh * 8;
    bf16x8 af[16], bfv[16];
#pragma unroll
    for (int ks = 0; ks < 16; ++ks) { af[ks] = *(const bf16x8*)(ap + ks * 16); bfv[ks] = *(const bf16x8*)(bp + ks * 16); }
    f32x16 acc;
#pragma unroll
    for (int i = 0; i < 16; ++i) acc[i] = 0.f;
#pragma unroll
    for (int ks = 0; ks < 16; ++ks) acc = MFMA32(af[ks], bfv[ks], acc);
#pragma unroll
    for (int i = 0; i < 16; ++i) { const int row = (i & 3) + 8 * (i >> 2) + 4 * hh; DTPp[((size_t)kq * MTOK + mt * 32 + row) * 32 + qc] = acc[i]; }
}

__global__ void __launch_bounds__(512, 2) mega_fwd(Params P) {
    extern __shared__ __attribute__((aligned(16))) unsigned char lds_raw[];
    cg::grid_group grid = cg::this_grid();
    LAS unsigned char* lds = (LAS unsigned char*)lds_raw;
    const int G = gridDim.x, bx = blockIdx.x, NGW = G * 8, NGT = G * 512;
    if (threadIdx.x < 2) ((LAS unsigned*)(lds + 147456))[threadIdx.x] = 0u;
    __syncthreads();
    (void)xcd_barrier_post((unsigned*)(P.ws + WS_BAR), (volatile LAS unsigned*)(lds + 147456));
#define GSYNC() do { XcdBarrier xb_; xb_.bar = (unsigned*)(P.ws + WS_BAR); xb_.x = xb_xcc_id(); xb_.st = (volatile LAS unsigned*)(lds + 147456); xcd_barrier(xb_); } while (0)
#define PHASE_BEGIN unsigned char* ws = P.ws; asm volatile("" : "+s"(ws)); int tid = threadIdx.x; asm volatile("" : "+v"(tid)); \
    const int lane = tid & 63, wave = __builtin_amdgcn_readfirstlane(tid >> 6), gw = bx * 8 + wave, gt = bx * 512 + tid; (void)lane; (void)gw; (void)gt; (void)ws;

    REP(1) { PHASE_BEGIN
        LAS float* scr = (LAS float*)(lds + wave * 16384);
        for (int it = gw; it < 2 * I_LAYER; it += NGW) convert_weight_item(P, ws, it / I_LAYER, it % I_LAYER, scr, lane);
        for (int i = gt; i < 2 * MTOK * PLE / 8; i += NGT) { const f32x4 a = *(const f32x4*)(P.in[I_P] + (size_t)i * 8), b = *(const f32x4*)(P.in[I_P] + (size_t)i * 8 + 4);
            u32x4 w; w.x = cvt_pk_bf16(a[0], a[1]); w.y = cvt_pk_bf16(a[2], a[3]); w.z = cvt_pk_bf16(b[0], b[1]); w.w = cvt_pk_bf16(b[2], b[3]);
            *(u32x4*)(PBF + (size_t)i * 8) = w; }
        for (int m = gw; m < MTOK; m += NGW) row_to_bf16_ss(P.in[I_X] + (size_t)m * DM, H + (size_t)m * DM, SSQ + m, lane);
        for (int i = gt; i < 5 * MTOK; i += NGT) SSQ[MTOK + i] = 0.f;
    }
    GSYNC();
    if (gridDim.x == 0x7fffffffu) grid.sync();
    if (EXP == 6) { for (int q = 0; q < 10; ++q) GSYNC(); }

#pragma unroll 1
    for (int L = 0; L < 2; ++L) {
        REP(2) { PHASE_BEGIN
          pg8::Gemm g{H, WT_IN + (size_t)L * WT_IN_STRIDE, MTOK, 20480, DM}; pg8::StaticOrder S; S.init(MTOK, 20480, G, bx);
          pg8::EpiBf16 E{PROJ, NP, SSQ + (size_t)L * MTOK}; pg8::gemm_phase<pg8::EpiBf16, pg8::StaticOrder>(lds, g, S, E, nullptr);
          for (int it = gw; it < 2048; it += NGW) dt_partial_item(H, WT_IN + (size_t)L * WT_IN_STRIDE + (size_t)C_DT * DM, DTP, it, lane);
        }
        GSYNC();

        REP(3) { PHASE_BEGIN
            const float* cw = P.in[I_CONV_W] + (size_t)L * 4 * CONVC; const float* cb = P.in[I_CONV_B] + (size_t)L * CONVC;
            REP(12) for (int it = gw; it < 256 * 24; it += NGW) {
                const int mt = it / 24, ct = it - mt * 24, m0 = mt * 32, c0 = ct * 128, bb = m0 >> 11, t0 = m0 & (SEQ - 1);
                LAS bf16_t* tile = (LAS bf16_t*)(lds + wave * 16384);
                const int chunk = lane & 15, c = c0 + chunk * 8;
                const f32x4 bi0 = *(const f32x4*)(cb + c), bi1 = *(const f32x4*)(cb + c + 4);
                f32x4 wa[4], wb[4];
#pragma unroll
                for (int k = 0; k < 4; ++k) { wa[k] = *(const f32x4*)(cw + k * CONVC + c); wb[k] = *(const f32x4*)(cw + k * CONVC + c + 4); }
                const int rg = lane >> 4;
                u32x4 xin[11];
#pragma unroll
                for (int q = 0; q < 11; ++q) { const int tt = t0 + rg * 8 - 3 + q;
                    xin[q] = (tt >= 0) ? *(const u32x4*)(PROJ + (size_t)(m0 + rg * 8 - 3 + q) * NP + C_XBC + c) : (u32x4){0u, 0u, 0u, 0u}; }
#pragma unroll
                for (int i = 0; i < 8; ++i) { const int row = rg * 8 + i, m = m0 + row;
                    f32x4 a0 = bi0, a1 = bi1;
#pragma unroll
                    for (int k = 0; k < 4; ++k) { const u32x4 x = xin[i + k];
                        a0[0] += wa[k][0] * bflo(x.x); a0[1] += wa[k][1] * bfhi(x.x); a0[2] += wa[k][2] * bflo(x.y); a0[3] += wa[k][3] * bfhi(x.y);
                        a1[0] += wb[k][0] * bflo(x.z); a1[1] += wb[k][1] * bfhi(x.z); a1[2] += wb[k][2] * bflo(x.w); a1[3] += wb[k][3] * bfhi(x.w); }
                    u32x4 w; w.x = cvt_pk_bf16(siluf_(a0[0]), siluf_(a0[1])); w.y = cvt_pk_bf16(siluf_(a0[2]), siluf_(a0[3]));
                    w.z = cvt_pk_bf16(siluf_(a1[0]), siluf_(a1[1])); w.w = cvt_pk_bf16(siluf_(a1[2]), siluf_(a1[3]));
                    (void)m;
                    if (ct >= 16) { const int gI = (ct - 16) & 3; bf16_t* fb = (ct < 20) ? BF : CF;
                        *(u32x4*)(fb + ((size_t)((((bb * 32 + (t0 >> 6)) * 4 + gI) * 2 + (mt & 1)) * 8 + (chunk >> 1))) * 512 + ((chunk & 1) * 32 + row) * 8) = w; }
                    if (ct < 20) *(LAS u32x4*)(tile + row * 136 + chunk * 8) = w; }
                if (ct < 20) { LDS_WAIT(); asm volatile("" ::: "memory");
                    const int bc = bb * 32 + (t0 >> 6);
                    if (ct < 16) wave_tile_transpose_store_frag<4>(tile, XT, bc * 64 + (c0 >> 5), mt & 1, lane);
                    else wave_tile_transpose_store_frag<4>(tile, BT, (bc * 4 + (ct - 16)) * 4, mt & 1, lane);
                    LDS_WAIT(); asm volatile("" ::: "memory"); }
            }
            REP(14) for (int it = gw; it < 4 * 12 * 64; it += NGW) {
                const int bb = it / 768, rem = it - bb * 768, head = rem >> 6, pb = rem & 63, sh = 2 * (head >> 2), dil = 1 << sh, ld = SEQ >> sh;
                const int pos0 = pb * 32, r = pos0 >> (11 - sh), s0 = pos0 & (ld - 1), chunk = lane & 15;
                LAS bf16_t* tile = (LAS bf16_t*)(lds + wave * 16384);
#pragma unroll
                for (int i = 0; i < 8; ++i) { const int row = i * 4 + (lane >> 4); const size_t m = (size_t)bb * SEQ + (size_t)(s0 + row) * dil + r;
                    *(LAS u32x4*)(tile + row * 136 + chunk * 8) = *(const u32x4*)(PROJ + m * NP + C_V + head * 128 + chunk * 8); }
                LDS_WAIT(); asm volatile("" ::: "memory");
                wave_tile_transpose_store_frag<2>(tile, VT, ((bb * 12 + head) * 64 + pb) * 4, 0, lane);
                LDS_WAIT(); asm volatile("" ::: "memory");
            }
            REP(18) for (int it = gw; it < 128 * 8; it += NGW) { const int m = (it >> 3) * 64 + lane;
#pragma unroll 2
                for (int h = (it & 7) * 4; h < (it & 7) * 4 + 4; ++h) {
                    float rawp = 0.f;
#pragma unroll
                    for (int kq = 0; kq < 8; ++kq) rawp += DTP[((size_t)kq * MTOK + m) * 32 + h];
                    const float raw = P.in[I_DT_BIAS][L * 32 + h] + rawp * rsqrtf(SSQ[(size_t)L * MTOK + m] * (1.f / 2048.f) + RMS_EPS);
                    const float dt = fmaxf(raw, 0.f) + __logf(1.f + __expf(-fabsf(raw)));
                    float cum = -dt * __expf(P.in[I_A_LOG][L * 32 + h]);
#pragma unroll
                    for (int o = 1; o < 64; o <<= 1) { const float v = __shfl_up(cum, o); if (lane >= o) cum += v; }
                    const size_t di = ((size_t)(it >> 3) * 32 + h) * 64 + lane;
                    DT[di] = dt; DA[di] = cum * 1.4426950408889634f; } }
            REP(13) for (int it = gw; it < 512 * 4; it += NGW) {
                const int run = it >> 2, g = it & 3, m0 = run * 16, t0 = m0 & (SEQ - 1);
                const bf16_t* up = PROJ + C_UPOOL + g * 512 + lane * 8; bf16_t* outp = POOLED + ((size_t)g * MTOK + m0) * 512 + lane * 8;
                if (g == 0) pooled_run<2>(up, outp, m0, t0); else if (g == 1) pooled_run<4>(up, outp, m0, t0); else if (g == 2) pooled_run<8>(up, outp, m0, t0); else pooled_run<16>(up, outp, m0, t0);
            }
            REP(15) for (int tg = gw; tg < MTOK / 4; tg += NGW) {
                const int m = tg * 4 + (lane >> 4), d = (lane & 15) * 8, tq = m & (SEQ - 1), gr = lane & 15;
#pragma unroll 1
                for (int hb = 0; hb < 24; hb += 8) {
                    u32x4 xq[8];
#pragma unroll
                    for (int u = 0; u < 8; ++u) { const int hh = hb + u, isk = (hh >= 12) ? 1 : 0, head = hh - 12 * isk;
                        xq[u] = *(const u32x4*)(PROJ + (size_t)m * NP + (isk ? C_K : C_Q) + head * 128 + d); }
#pragma unroll
                    for (int u = 0; u < 8; ++u) { const int hh = hb + u, isk = (hh >= 12) ? 1 : 0, head = hh - 12 * isk;
                        const u32x4 x = xq[u];
                        const float f0 = bflo(x.x), f1 = bfhi(x.x), f2 = bflo(x.y), f3 = bfhi(x.y), f4 = bflo(x.z), f5 = bfhi(x.z), f6 = bflo(x.w), f7 = bfhi(x.w);
                        float ss = (f0 * f0 + f1 * f1) + (f2 * f2 + f3 * f3) + (f4 * f4 + f5 * f5) + (f6 * f6 + f7 * f7);
                        ss += __shfl_xor(ss, 1); ss += __shfl_xor(ss, 2); ss += __shfl_xor(ss, 4); ss += __shfl_xor(ss, 8);
                        const float rinv = rsqrtf(ss * (1.f / 128.f) + RMS_EPS);
                        const float* gg = (isk ? P.in[I_K_NORM_G] : P.in[I_Q_NORM_G]) + L * 128 + d;
                        const f32x4 g0 = *(const f32x4*)gg, g1 = *(const f32x4*)(gg + 4);
                        u32x4 o; o.x = cvt_pk_bf16(f0 * rinv * g0[0], f1 * rinv * g0[1]); o.y = cvt_pk_bf16(f2 * rinv * g0[2], f3 * rinv * g0[3]);
                        o.z = cvt_pk_bf16(f4 * rinv * g1[0], f5 * rinv * g1[1]); o.w = cvt_pk_bf16(f6 * rinv * g1[2], f7 * rinv * g1[3]);
                        const int sh = 2 * (head >> 2), pos = ((tq & ((1 << sh) - 1)) << (11 - sh)) + (tq >> sh);
                        *(u32x4*)((isk ? KN : QN) + ((size_t)((((m >> 11) * 12 + head) * 64 + (pos >> 5)) * 8 + (gr >> 1))) * 512 + ((gr & 1) * 32 + (pos & 31)) * 8) = o; }
                }
            }
        }
        GSYNC();

        REP(4) { PHASE_BEGIN
            __syncthreads();
            REP(7) for (int item = bx; item < 128; item += G)
                ssd_block(lds, CF, BF, XT, BT, DT, DA, YSSD, PROJ + C_ZSSD, SSQ + (size_t)(4 + L) * MTOK, P.in[I_D_SKIP][L * 32 + (item & 31)], item >> 5, item & 31, tid);
            { const int nb0 = (G > 128) ? 128 : 0;
              REP(8) if (bx >= nb0) for (int it = (bx - nb0) * 8 + wave; it < 3072; it += (G - nb0) * 8) attn_item(QN, KN, VT, OG, LSE, it, lane); }
            __syncthreads();
            REP(9) { pg8::Gemm g{POOLED, WT_POOL + (size_t)L * 4 * 512 * 512, 4 * MTOK, 2048, 512}; pg8::PoolOrder S{(G > 128) ? G - 128 : G, (G > 128) ? ((bx >= 128) ? bx - 128 : 1000000) : bx};
              pg8::EpiPool E{YPOOL, PROJ + C_ZPOOL, NP, P.in[I_POOL_SCALE] + L * 2048};
              pg8::gemm_phase<pg8::EpiPool, pg8::PoolOrder>(lds, g, S, E, nullptr); }
            { pg8::Gemm g{PBF + (size_t)L * MTOK * PLE, WT_PROJ + (size_t)L * PLE * DM, MTOK, DM, PLE}; pg8::EpiF32 E{PP, DM};
              pg8::StaticOrder S; S.init(MTOK, DM, (G > 128) ? G - 128 : G, (G > 128) ? ((bx >= 128) ? bx - 128 : (1 << 28)) : bx);
              pg8::gemm_phase<pg8::EpiF32, pg8::StaticOrder>(lds, g, S, E, nullptr); }
            if (false) { const int nb0 = (G > 128) ? 128 : 0; LAS float* scr = (LAS float*)(lds + wave * 16384);
                if (bx >= nb0) for (int it = (bx - nb0) * 8 + wave; it < I_LAYER; it += (G - nb0) * 8) convert_weight_item(P, ws, 1, it, scr, lane); }
        }
        GSYNC();

        REP(5) { PHASE_BEGIN
        for (int m = gw; m < MTOK; m += NGW) { const int col = lane * 8, j = lane >> 4;
            const float l0 = LSE[((size_t)0 * MTOK + m) * 4 + j], l1 = LSE[((size_t)1 * MTOK + m) * 4 + j], l2 = LSE[((size_t)2 * MTOK + m) * 4 + j];
            const float lm = fmaxf(l0, fmaxf(l1, l2)); float w0 = __expf(l0 - lm), w1 = __expf(l1 - lm), w2 = __expf(l2 - lm); const float iw = 1.f / (w0 + w1 + w2); w0 *= iw; w1 *= iw; w2 *= iw;
            const u32x4 a = *(const u32x4*)(OG + ((size_t)0 * MTOK + m) * 512 + col), bq = *(const u32x4*)(OG + ((size_t)1 * MTOK + m) * 512 + col), cq = *(const u32x4*)(OG + ((size_t)2 * MTOK + m) * 512 + col);
            const u32x4 z = *(const u32x4*)(PROJ + (size_t)m * NP + C_ZATTN + col);
            u32x4 o;
            o.x = cvt_pk_bf16((w0 * bflo(a.x) + w1 * bflo(bq.x) + w2 * bflo(cq.x)) * siluf_(bflo(z.x)), (w0 * bfhi(a.x) + w1 * bfhi(bq.x) + w2 * bfhi(cq.x)) * siluf_(bfhi(z.x)));
            o.y = cvt_pk_bf16((w0 * bflo(a.y) + w1 * bflo(bq.y) + w2 * bflo(cq.y)) * siluf_(bflo(z.y)), (w0 * bfhi(a.y) + w1 * bfhi(bq.y) + w2 * bfhi(cq.y)) * siluf_(bfhi(z.y)));
            o.z = cvt_pk_bf16((w0 * bflo(a.z) + w1 * bflo(bq.z) + w2 * bflo(cq.z)) * siluf_(bflo(z.z)), (w0 * bfhi(a.z) + w1 * bfhi(bq.z) + w2 * bfhi(cq.z)) * siluf_(bfhi(z.z)));
            o.w = cvt_pk_bf16((w0 * bflo(a.w) + w1 * bflo(bq.w) + w2 * bflo(cq.w)) * siluf_(bflo(z.w)), (w0 * bfhi(a.w) + w1 * bfhi(bq.w) + w2 * bfhi(cq.w)) * siluf_(bfhi(z.w)));
            *(u32x4*)(YATTN + (size_t)m * 512 + col) = o; }
        }
        GSYNC();

        REP(10) { PHASE_BEGIN pg8::StaticOrder S; S.init(MTOK, DM, G, bx);
          pg8::Merge3 g{YSSD, YPOOL, YATTN, WT_BRSSD + (size_t)L * DM * DM, WT_BRPOOL + (size_t)L * DM * DM, WT_BRATTN + (size_t)L * 512 * DM, DM, DM, 512, PROJ + C_GATES, NP, MB, SSQ + (size_t)(4 + L) * MTOK};
          pg8::gemm_merge3<pg8::StaticOrder>(lds, g, S); }
        GSYNC();

        { PHASE_BEGIN pg8::StaticOrder S; S.init(MTOK, DM, G, bx);
          pg8::Gemm g{MB, WT_OUT + (size_t)L * DM * DM, MTOK, DM, DM};
          if (L == 0) { pg8::EpiResid<false> E{P.in[I_X], H, H2, SSQ + (size_t)2 * MTOK}; pg8::gemm_phase<pg8::EpiResid<false>, pg8::StaticOrder>(lds, g, S, E, nullptr); }
          else { pg8::EpiResid<true> E{P.in[I_X], H, H2, SSQ + (size_t)3 * MTOK}; pg8::gemm_phase<pg8::EpiResid<true>, pg8::StaticOrder>(lds, g, S, E, nullptr); } }
        GSYNC();

        { PHASE_BEGIN pg8::StaticOrder S; S.init(MTOK, DM, G, bx);
          pg8::Gemm g{H2, WT_GATE + (size_t)L * DM * DM, MTOK, DM, DM};
          if (L == 0) { pg8::EpiPle<true> E{PP, H2, P.out, SSQ + (size_t)2 * MTOK, H, SSQ + (size_t)MTOK}; pg8::gemm_phase<pg8::EpiPle<true>, pg8::StaticOrder>(lds, g, S, E, nullptr); }
          else { pg8::EpiPle<false> E{PP, H2, P.out, SSQ + (size_t)3 * MTOK, H, SSQ + (size_t)MTOK}; pg8::gemm_phase<pg8::EpiPle<false>, pg8::StaticOrder>(lds, g, S, E, nullptr); } }
        if (L == 0) GSYNC();
    }
}

extern "C" void kernel_launch(void* const* d_in, const int* in_sizes, int n_in, void* d_out, int out_size, void* d_ws, size_t ws_size, hipStream_t stream) {
    static int grid_blocks = 0;
    if (grid_blocks == 0) {
        if (n_in != 21 || out_size != MTOK * DM || ws_size < WS_END) { fprintf(stderr, "kernel_launch: unexpected shapes: n_in %d out %d ws %zu (need %zu)\n", n_in, out_size, ws_size, (size_t)WS_END); grid_blocks = -1; return; }
        int dev = 0, cus = 0, per_cu = 0;
        hipGetDevice(&dev);
        hipDeviceGetAttribute(&cus, hipDeviceAttributeMultiprocessorCount, dev);
        if (hipFuncSetAttribute((const void*)mega_fwd, hipFuncAttributeMaxDynamicSharedMemorySize, LDS_BYTES) != hipSuccess) { fprintf(stderr, "kernel_launch: hipFuncSetAttribute failed\n"); grid_blocks = -1; return; }
        if (hipOccupancyMaxActiveBlocksPerMultiprocessor(&per_cu, (const void*)mega_fwd, 512, LDS_BYTES) != hipSuccess || per_cu < 1) { fprintf(stderr, "kernel_launch: occupancy query gave %d\n", per_cu); per_cu = 1; (void)hipGetLastError(); }
        grid_blocks = cus * (per_cu > 1 ? 1 : per_cu);
    }
    if (grid_blocks < 0) return;
    if (hipMemsetAsync((char*)d_ws + WS_BAR, 0, 16384, stream) != hipSuccess) { fprintf(stderr, "kernel_launch: memset of the barrier words failed\n"); return; }
    Params p{};
    for (int i = 0; i < 21; ++i) p.in[i] = (const float*)d_in[i];
    p.out = (float*)d_out; p.ws = (unsigned char*)d_ws;
    void* args[] = {&p};
    hipError_t e = hipLaunchCooperativeKernel((const void*)mega_fwd, dim3(grid_blocks), dim3(512), args, LDS_BYTES, stream);
    if (e != hipSuccess) fprintf(stderr, "cooperative launch failed: %s (grid %d)\n", hipGetErrorString(e), grid_blocks);
}
```
